# Optimizing an MI355X kernel written in HIP

```python
import jax, jax.numpy as jnp
from jax import lax
import numpy as np

D_MODEL = 1024
BATCH = 8
SEQ = 8192
DEPTH = 2
DEC_BATCH = 4
DEC_SEQ = 4096
PAST_LEN = 128

HEAD_DIM = 64
A_Q_HEADS = 8
A_KV_HEADS = 2
WINDOW = 128
A_BLOCK = 128
B_HEADS = 4
GRID_W = 64
NB_ROWS_MAX = 8
NB_COLS = 16
M_HEADS = 4
N_MEM = 256
D_FF = 4 * D_MODEL
EPS = 1e-6

A_Q = A_Q_HEADS * HEAD_DIM
A_KV = A_KV_HEADS * HEAD_DIM
B_W = B_HEADS * HEAD_DIM
M_W = M_HEADS * HEAD_DIM
MIX_W = A_Q + B_W + M_W
IN_W = A_Q + 2 * A_KV + 3 * B_W + M_W
SPLITS = [A_Q, A_Q + A_KV, A_Q + 2 * A_KV, A_Q + 2 * A_KV + B_W,
          A_Q + 2 * A_KV + 2 * B_W, A_Q + 2 * A_KV + 3 * B_W]

kernel_name = "hybrid_window_natten_memory_encoder"


def _rmsnorm(x, g):
    xf = x.astype(jnp.float32)
    y = xf * lax.rsqrt(jnp.mean(jnp.square(xf), axis=-1, keepdims=True) + EPS)
    return (y * g.astype(jnp.float32)).astype(x.dtype)


def _alibi_slopes(n):
    return jnp.exp2(-8.0 * jnp.arange(1, n + 1, dtype=jnp.float32) / n)


def _window_gqa(q, k, v, sink):
    B, S = q.shape[0], q.shape[1]
    nb = S // A_BLOCK
    G = A_Q_HEADS // A_KV_HEADS
    qb = q.reshape(B, nb, A_BLOCK, A_KV_HEADS, G, HEAD_DIM)
    pad = ((0, 0), (A_BLOCK, A_BLOCK), (0, 0), (0, 0))

    def band(t):
        tb = jnp.pad(t, pad).reshape(B, nb + 2, A_BLOCK, A_KV_HEADS, HEAD_DIM)
        return jnp.concatenate([tb[:, :-2], tb[:, 1:-1], tb[:, 2:]], axis=2)

    kb, vb = band(k), band(v)
    s = jnp.einsum('bnqhgd,bnshd->bnhgqs', qb, kb,
                   preferred_element_type=jnp.float32) * (HEAD_DIM ** -0.5)
    qi = jnp.arange(A_BLOCK)
    si = jnp.arange(3 * A_BLOCK)
    dist = jnp.abs(si[None, :] - A_BLOCK - qi[:, None]).astype(jnp.float32)
    kpos = jnp.arange(nb)[:, None] * A_BLOCK - A_BLOCK + si[None, :]
    valid = (dist <= WINDOW)[None] & ((kpos >= 0) & (kpos < S))[:, None, :]
    slopes = _alibi_slopes(A_Q_HEADS).reshape(A_KV_HEADS, G)
    s = s - slopes[:, :, None, None] * dist
    s = jnp.where(valid[None, :, None, None], s, -jnp.inf)
    sk = sink.astype(jnp.float32).reshape(A_KV_HEADS, G)[None, None, :, :, None, None]
    m = jnp.maximum(jnp.max(s, axis=-1, keepdims=True), sk)
    p = jnp.exp(s - m)
    p = p / (jnp.sum(p, axis=-1, keepdims=True) + jnp.exp(sk - m))
    o = jnp.einsum('bnhgqs,bnshd->bnqhgd', p.astype(v.dtype), vb)
    return o.reshape(B, S, A_Q)


def _neighborhood_attn(q, k, v, rpb):
    B, S = q.shape[0], q.shape[1]
    rows = S // GRID_W
    kh = min(NB_ROWS_MAX, rows)
    r = jnp.arange(rows)
    ridx = jnp.clip(r - kh // 2, 0, rows - kh)[:, None] + jnp.arange(kh)[None, :]
    c = jnp.arange(GRID_W)
    cstart = jnp.clip(c - NB_COLS // 2, 0, GRID_W - NB_COLS)
    cvalid = (c[None, :] >= cstart[:, None]) & (c[None, :] < cstart[:, None] + NB_COLS)
    qg = q.reshape(B, rows, GRID_W, B_HEADS, HEAD_DIM)
    kg = k.reshape(B, rows, GRID_W, B_HEADS, HEAD_DIM)[:, ridx]
    vg = v.reshape(B, rows, GRID_W, B_HEADS, HEAD_DIM)[:, ridx]
    s = jnp.einsum('brqhd,brkwhd->brhqkw', qg, kg,
                   preferred_element_type=jnp.float32) * (HEAD_DIM ** -0.5)
    dr = ridx - r[:, None] + (NB_ROWS_MAX - 1)
    dc = jnp.clip(c[None, :] - c[:, None] + (NB_COLS - 1), 0, 2 * NB_COLS - 2)
    bias = rpb.astype(jnp.float32)[:, dr[:, None, :, None], dc[None, :, None, :]]
    s = s + jnp.transpose(bias, (1, 0, 2, 3, 4))[None]
    s = jnp.where(cvalid[:, None, :][None, None, None], s, -jnp.inf)
    sh = s.shape
    p = jax.nn.softmax(s.reshape(sh[:4] + (kh * GRID_W,)), axis=-1).reshape(sh)
    o = jnp.einsum('brhqkw,brkwhd->brqhd', p.astype(v.dtype), vg)
    return o.reshape(B, S, B_W)


def _memory_attn(q, k, v):
    B, S = q.shape[0], q.shape[1]
    s = jnp.einsum('bshd,bmhd->bhsm', q, k, preferred_element_type=jnp.float32) * (HEAD_DIM ** -0.5)
    p = jax.nn.softmax(s, axis=-1)
    o = jnp.einsum('bhsm,bmhd->bshd', p.astype(v.dtype), v)
    return o.reshape(B, S, M_W)


def _trunk(x, mem, g_mix, w_in, qk_gain, sink, rpb, o_gain, w_out, g_mem, w_mem_kv, g_ff, w_ff1, w_ff2):
    B, S, _ = x.shape
    for l in range(DEPTH):
        h = _rmsnorm(x, g_mix[l])
        proj = h @ w_in[l]
        qa, ka, va, qb, kb, vb, qm = jnp.split(proj, SPLITS, axis=-1)
        qa = _rmsnorm(qa.reshape(B, S, A_Q_HEADS, HEAD_DIM), qk_gain[l, 0])
        ka = _rmsnorm(ka.reshape(B, S, A_KV_HEADS, HEAD_DIM), qk_gain[l, 1])
        va = va.reshape(B, S, A_KV_HEADS, HEAD_DIM)
        oa = _window_gqa(qa, ka, va, sink[l])
        qb = _rmsnorm(qb.reshape(B, S, B_HEADS, HEAD_DIM), qk_gain[l, 2])
        kb = _rmsnorm(kb.reshape(B, S, B_HEADS, HEAD_DIM), qk_gain[l, 3])
        vb = vb.reshape(B, S, B_HEADS, HEAD_DIM)
        ob = _neighborhood_attn(qb, kb, vb, rpb[l])
        mkv = _rmsnorm(mem, g_mem[l]) @ w_mem_kv[l]
        km, vm = jnp.split(mkv, 2, axis=-1)
        km = _rmsnorm(km.reshape(B, N_MEM, M_HEADS, HEAD_DIM), qk_gain[l, 5])
        vm = vm.reshape(B, N_MEM, M_HEADS, HEAD_DIM)
        qm = _rmsnorm(qm.reshape(B, S, M_HEADS, HEAD_DIM), qk_gain[l, 4])
        om = _memory_attn(qm, km, vm)
        og = o_gain[l]
        o = jnp.concatenate([_rmsnorm(oa, og[:A_Q]),
                             _rmsnorm(ob, og[A_Q:A_Q + B_W]),
                             _rmsnorm(om, og[A_Q + B_W:])], axis=-1)
        x = x + o @ w_out[l]
        f = _rmsnorm(x, g_ff[l]) @ w_ff1[l]
        x = x + jnp.square(jax.nn.relu(f)) @ w_ff2[l]
    return x


def setup_inputs(seed: int = 0) -> dict:
    key = jax.random.key(seed)
    ks = jax.random.split(key, 16)
    f32 = jnp.float32
    nrm = lambda k, shape: jax.random.normal(k, shape, dtype=f32)
    return {
        "x_prompt": nrm(ks[0], (BATCH, SEQ, D_MODEL)),
        "x_sample": nrm(ks[1], (DEC_BATCH, DEC_SEQ, D_MODEL)),
        "mem_prompt": nrm(ks[2], (BATCH, N_MEM, D_MODEL)),
        "mem_sample": nrm(ks[3], (DEC_BATCH, N_MEM, D_MODEL)),
        "g_mix": 1.0 + 0.02 * nrm(ks[4], (DEPTH, D_MODEL)),
        "w_in": nrm(ks[5], (DEPTH, D_MODEL, IN_W)) * D_MODEL ** -0.5,
        "qk_gain": 1.0 + 0.02 * nrm(ks[6], (DEPTH, 6, HEAD_DIM)),
        "sink": 0.5 * nrm(ks[7], (DEPTH, A_Q_HEADS)),
        "rpb": 0.1 * nrm(ks[8], (DEPTH, B_HEADS, 2 * NB_ROWS_MAX - 1, 2 * NB_COLS - 1)),
        "o_gain": 1.0 + 0.02 * nrm(ks[9], (DEPTH, MIX_W)),
        "w_out": nrm(ks[10], (DEPTH, MIX_W, D_MODEL)) * MIX_W ** -0.5,
        "g_mem": 1.0 + 0.02 * nrm(ks[11], (DEPTH, D_MODEL)),
        "w_mem_kv": nrm(ks[12], (DEPTH, D_MODEL, 2 * M_W)) * D_MODEL ** -0.5,
        "g_ff": 1.0 + 0.02 * nrm(ks[13], (DEPTH, D_MODEL)),
        "w_ff1": nrm(ks[14], (DEPTH, D_MODEL, D_FF)) * D_MODEL ** -0.5,
        "w_ff2": nrm(ks[15], (DEPTH, D_FF, D_MODEL)) * D_FF ** -0.5,
    }


def reference(x_prompt, x_sample, mem_prompt, mem_sample, g_mix, w_in, qk_gain, sink, rpb,
              o_gain, w_out, g_mem, w_mem_kv, g_ff, w_ff1, w_ff2):
    y_prompt = _trunk(x_prompt, mem_prompt, g_mix, w_in, qk_gain, sink, rpb, o_gain, w_out,
                      g_mem, w_mem_kv, g_ff, w_ff1, w_ff2)
    y_sample = _trunk(x_sample, mem_sample, g_mix, w_in, qk_gain, sink, rpb, o_gain, w_out,
                      g_mem, w_mem_kv, g_ff, w_ff1, w_ff2)
    return (y_prompt, y_sample)
```

```cpp
#include <hip/hip_runtime.h>
#include <hip/hip_cooperative_groups.h>
#include <cstdio>
#include <cstdint>
namespace cg = cooperative_groups;

#define LAS __attribute__((address_space(3)))
#define DI __device__ __forceinline__
typedef unsigned short bf16_t;
typedef short bf16x8 __attribute__((ext_vector_type(8)));
typedef float f32x4 __attribute__((ext_vector_type(4)));
typedef float f32x16 __attribute__((ext_vector_type(16)));
typedef unsigned u32x4 __attribute__((ext_vector_type(4)));
typedef unsigned u32x2 __attribute__((ext_vector_type(2)));
typedef short s16x4 __attribute__((ext_vector_type(4)));

constexpr int DM = 1024, NTOK = 81920, NPROMPT = 65536, INW = 1792, DFF = 4096, NMEMROWS = 3072;
constexpr float EPS = 1e-6f, LOG2E = 1.4426950408889634f, QSCALE = 0.125f * 1.4426950408889634f;

DI unsigned pk_bf16(float lo, float hi) {
    typedef float f2 __attribute__((ext_vector_type(2))); typedef __bf16 b2 __attribute__((ext_vector_type(2)));
    f2 v = {lo, hi}; b2 o = __builtin_convertvector(v, b2); return __builtin_bit_cast(unsigned, o);
}
DI float dot4(f32x4 a) { return (a[0] * a[0] + a[1] * a[1]) + (a[2] * a[2] + a[3] * a[3]); }
DI float bf_lo(unsigned u) { return __uint_as_float(u << 16); }
DI float bf_hi(unsigned u) { return __uint_as_float(u & 0xffff0000u); }

namespace pg8 {
constexpr int BM = 256, BK = 64, HALF = 128, HTB = HALF * BK * 2, STAGE_BYTES = 8 * HTB, NXCD = 8, WGM = 8;
constexpr int EPI_RS = STAGE_BYTES, EPI_P = STAGE_BYTES + 1024;

__host__ __device__ __forceinline__ int lds_byte(int r, int c) { const int st = (r >> 4) * 2 + (c >> 5), rr = r & 15, cc = c & 31, ob = rr * 64 + cc * 2; return st * 1024 + (ob ^ (((ob >> 9) & 1) << 5)); }
__host__ __device__ __forceinline__ void stage_rc(int b, int& R, int& C) { const int st = b / 1024, sb = b % 1024, swz = sb ^ (((sb >> 9) & 1) << 5); R = (st >> 1) * 16 + swz / 64; C = (st & 1) * 32 + (swz % 64) / 2; }
__host__ __device__ __forceinline__ int perm32(int rho) { const int n = rho >> 4, i = rho & 15; return 8 * (i >> 2) + 4 * n + (i & 3); }

struct Unit { int pm, pn; };
struct Gemm { const bf16_t* A; const bf16_t* Bt; int M, N, K; };

struct StaticOrder {
    int nM, nN, nwg, G, c;
    __host__ __device__ void init(int M, int N, int G_, int c_) { nM = M / BM; nN = N / BM; nwg = nM * nN; G = G_; c = c_; }
    __host__ __device__ bool next(int i, Unit& u) const {
        const long L = (long)i * G + c; if (L >= nwg) return false;
        int wgid = (int)L; { const int q = nwg / NXCD, r = nwg % NXCD, xcd = wgid % NXCD, off = wgid / NXCD; wgid = (xcd < r ? xcd * (q + 1) : r * (q + 1) + (xcd - r) * q) + off; }
        const int nig = WGM * nN, gid = wgid / nig, fm = gid * WGM, gsz = (nM - fm) < WGM ? (nM - fm) : WGM;
        u.pm = fm + ((wgid % nig) % gsz); u.pn = (wgid % nig) / gsz; return true;
    }
    __device__ __forceinline__ void a_ready(const Unit&) const {}
    __device__ __forceinline__ void done(const Unit&) const {}
};


DI void stage_rstd(LAS unsigned char* lds0, const float* stats, int row0) {
    int tid = threadIdx.x; asm volatile("" : "+v"(tid));
    const f32x4* q = (const f32x4*)(stats + (size_t)(row0 + (tid >> 1)) * 16 + (tid & 1) * 8); const f32x4 a = q[0], b = q[1];
    float s = ((a[0] + a[1]) + (a[2] + a[3])) + ((b[0] + b[1]) + (b[2] + b[3]));
    s += __shfl_xor(s, 1);
    if ((tid & 1) == 0) ((LAS float*)(lds0 + EPI_RS))[tid >> 1] = rsqrtf(s * (1.0f / 1024.0f) + EPS);
}
#define EPI_BARRIER() do { asm volatile("s_waitcnt lgkmcnt(0)" ::: "memory"); __builtin_amdgcn_s_barrier(); asm volatile("" ::: "memory"); } while (0)

DI u32x4 xpose_fwd(u32x4 w, int lane) { const int src = ((((lane & 3) << 4) | (lane >> 2)) << 2); u32x4 o;
    o.x = (unsigned)__builtin_amdgcn_ds_bpermute(src, (int)w.x); o.y = (unsigned)__builtin_amdgcn_ds_bpermute(src, (int)w.y); o.z = (unsigned)__builtin_amdgcn_ds_bpermute(src, (int)w.z); o.w = (unsigned)__builtin_amdgcn_ds_bpermute(src, (int)w.w); return o; }
DI u32x4 xpose_inv(u32x4 w, int lane) { const int src = ((((lane & 15) << 2) | (lane >> 4)) << 2); u32x4 o;
    o.x = (unsigned)__builtin_amdgcn_ds_bpermute(src, (int)w.x); o.y = (unsigned)__builtin_amdgcn_ds_bpermute(src, (int)w.y); o.z = (unsigned)__builtin_amdgcn_ds_bpermute(src, (int)w.z); o.w = (unsigned)__builtin_amdgcn_ds_bpermute(src, (int)w.w); return o; }

struct EpiProj {
    static constexpr bool PERM = true, AFTER_DRAIN = false;
    bf16_t* O; int ldc; const float* stats; const float* gains; int mode; LAS unsigned char* lds0;
    DI void cfg(int pn, int bj, int& gi, float& mult) const {
        gi = -1; mult = 1.f;
        if (mode == 0) {
            if (pn <= 1) { gi = 0; mult = QSCALE; }
            else if (pn == 2) { if (bj == 0) gi = 1; }
            else if (pn == 3) { gi = 2; mult = QSCALE; }
            else if (pn == 4) { gi = 3; }
            else if (pn == 6) { gi = 4; mult = QSCALE; }
        } else { if (pn == 0) gi = 5; else if (pn == 2) gi = 11; }
    }
    DI void operator()(const f32x4 (&acc)[2][2][4][2], const Unit& u, int wr, int wc, int fr, int fq) const {
        stage_rstd(lds0, stats, u.pm * BM);
        LAS float* P = (LAS float*)(lds0 + EPI_P); const LAS float* rs = (const LAS float*)(lds0 + EPI_RS);
#pragma unroll
        for (int ai = 0; ai < 2; ++ai)
#pragma unroll
            for (int m = 0; m < 4; ++m)
#pragma unroll
                for (int bj = 0; bj < 2; ++bj) {
                    float s = dot4(acc[ai][bj][m][0]) + dot4(acc[ai][bj][m][1]);
                    s += __shfl_xor(s, 16); s += __shfl_xor(s, 32);
                    if (fq == 0) P[(bj * 256 + ai * HALF + wr * 64 + m * 16 + fr) * 4 + wc] = s;
                }
        EPI_BARRIER();
#pragma unroll
        for (int bj = 0; bj < 2; ++bj) {
            int gi; float mult; cfg(u.pn, bj, gi, mult);
            f32x4 g0 = {1.f, 1.f, 1.f, 1.f}, g1 = {1.f, 1.f, 1.f, 1.f};
            if (gi >= 0) { const float* gp = gains + gi * 64 + (wc & 1) * 32 + 8 * fq; g0 = *(const f32x4*)gp; g1 = *(const f32x4*)(gp + 4); }
#pragma unroll
            for (int ai = 0; ai < 2; ++ai)
#pragma unroll
                for (int m = 0; m < 4; ++m) {
                    const int rl = ai * HALF + wr * 64 + m * 16 + fr; const float rstd = rs[rl]; float sc = rstd;
                    if (gi >= 0) { const int pi = (bj * 256 + rl) * 4 + (wc & 2); const float tot = P[pi] + P[pi + 1]; sc = rstd * rsqrtf(tot * rstd * rstd * (1.0f / 64.0f) + EPS) * mult; }
                    const f32x4 v0 = acc[ai][bj][m][0] * sc * g0, v1 = acc[ai][bj][m][1] * sc * g1;
                    u32x4 w; w.x = pk_bf16(v0[0], v0[1]); w.y = pk_bf16(v0[2], v0[3]); w.z = pk_bf16(v1[0], v1[1]); w.w = pk_bf16(v1[2], v1[3]);
                    { const int ln = fq * 16 + fr; __builtin_nontemporal_store(xpose_fwd(w, ln), (u32x4*)(O + (size_t)(u.pm * BM + rl - fr + (ln >> 2)) * ldc + u.pn * BM + bj * HALF + wc * 32 + 8 * (ln & 3))); }
                    if (m & 1) asm volatile("" ::: "memory");
                }
        }
    }
};

struct EpiRes {
    static constexpr bool PERM = true, AFTER_DRAIN = false;
    bf16_t* xb; float* outf; const float* rstats; float* wstats; LAS unsigned char* lds0;
    DI void operator()(const f32x4 (&acc)[2][2][4][2], const Unit& u, int wr, int wc, int fr, int fq) const {
        const LAS float* rs = (const LAS float*)(lds0 + EPI_RS);
        if (rstats) { stage_rstd(lds0, rstats, u.pm * BM); EPI_BARRIER(); }
        const int col0 = u.pn * BM + wc * 32 + 8 * fq;
#pragma unroll
        for (int ai = 0; ai < 2; ++ai)
#pragma unroll
            for (int m = 0; m < 4; ++m) {
                const int rl = ai * HALF + wr * 64 + m * 16 + fr; const size_t grow = (size_t)(u.pm * BM + rl);
                float sc = 1.0f; if (rstats) { const float r_ = rs[rl]; sc = r_ * r_; }
                float ss = 0.f;
#pragma unroll
                for (int bj = 0; bj < 2; ++bj) {
                    const int c = col0 + bj * HALF;
                    const int ln = fq * 16 + fr; const size_t grow2 = grow - fr + (ln >> 2); const int c2 = u.pn * BM + wc * 32 + bj * HALF + 8 * (ln & 3);
                    const u32x4 b = xpose_inv(*(const u32x4*)(xb + grow2 * DM + c2), ln);
                    const f32x4 b0 = {bf_lo(b.x), bf_hi(b.x), bf_lo(b.y), bf_hi(b.y)}, b1 = {bf_lo(b.z), bf_hi(b.z), bf_lo(b.w), bf_hi(b.w)};
                    const f32x4 v0 = acc[ai][bj][m][0] * sc + b0, v1 = acc[ai][bj][m][1] * sc + b1;
                    if (outf) { const u32x4 t0 = xpose_fwd(__builtin_bit_cast(u32x4, v0), ln), t1 = xpose_fwd(__builtin_bit_cast(u32x4, v1), ln);
                                __builtin_nontemporal_store(t0, (u32x4*)(outf + grow2 * DM + c2)); __builtin_nontemporal_store(t1, (u32x4*)(outf + grow2 * DM + c2 + 4)); }
                    else { u32x4 w; w.x = pk_bf16(v0[0], v0[1]); w.y = pk_bf16(v0[2], v0[3]); w.z = pk_bf16(v1[0], v1[1]); w.w = pk_bf16(v1[2], v1[3]); *(u32x4*)(xb + grow2 * DM + c2) = xpose_fwd(w, ln); }
                    ss += dot4(v0) + dot4(v1);
                }
                if (!outf) { ss += __shfl_xor(ss, 16); ss += __shfl_xor(ss, 32); if (fq == 0) wstats[grow * 16 + u.pn * 4 + wc] = ss; }
                if (m & 1) asm volatile("" ::: "memory");
            }
    }
};

struct EpiFF1 {
    static constexpr bool PERM = true, AFTER_DRAIN = false;
    bf16_t* O;
    DI void operator()(const f32x4 (&acc)[2][2][4][2], const Unit& u, int wr, int wc, int fr, int fq) const {
#pragma unroll
        for (int ai = 0; ai < 2; ++ai)
#pragma unroll
            for (int m = 0; m < 4; ++m) {
                const int rl = ai * HALF + wr * 64 + m * 16 + fr;
#pragma unroll
                for (int bj = 0; bj < 2; ++bj) {
                    f32x4 v0 = acc[ai][bj][m][0], v1 = acc[ai][bj][m][1];
#pragma unroll
                    for (int e = 0; e < 4; ++e) { const float a = fmaxf(v0[e], 0.f), b = fmaxf(v1[e], 0.f); v0[e] = a * a; v1[e] = b * b; }
                    u32x4 w; w.x = pk_bf16(v0[0], v0[1]); w.y = pk_bf16(v0[2], v0[3]); w.z = pk_bf16(v1[0], v1[1]); w.w = pk_bf16(v1[2], v1[3]);
                    { const int ln = fq * 16 + fr; __builtin_nontemporal_store(xpose_fwd(w, ln), (u32x4*)(O + (size_t)(u.pm * BM + rl - fr + (ln >> 2)) * DFF + u.pn * BM + bj * HALF + wc * 32 + 8 * (ln & 3))); }
                }
            }
    }
};

template <class Epi, class Sched, bool ALIGN_EPI = false, bool SP2 = false>
__device__ __forceinline__ void gemm_phase(LAS unsigned char* lds, const Gemm g, const Sched& S, const Epi& E) {
    int tid_ = threadIdx.x; asm volatile("" : "+v"(tid_));
    const int tid = tid_, wid = __builtin_amdgcn_readfirstlane(tid >> 6), lane = tid & 63, wr = wid >> 2, wc = wid & 3, fr = lane & 15, fq = lane >> 4;
    const int K = g.K, nt = K / BK;
    unsigned voffA[2], voffB[2];
#pragma unroll
    for (int i = 0; i < 2; ++i) { int R, C; stage_rc(tid * 16 + i * 8192, R, C); const int Rb = Epi::PERM ? ((R & ~31) + perm32(R & 31)) : R;
        voffA[i] = (unsigned)(R * K + C) * 2u; voffB[i] = (unsigned)(Rb * K + C) * 2u; }
    const size_t kstep = (size_t)(BK * 2);
    const size_t hstep = (size_t)HALF * K * 2;
    const size_t tstep = 2 * hstep;
    const unsigned ldsw = (unsigned)wid * 1024u;
    const int aoff = lds_byte(wr * 64 + fr, fq * 8), boff = lds_byte(wc * 32 + fr, fq * 8);
#define PG8_SA(b, h) (((b) * 2 + (h)) * HTB)
#define PG8_SB(b, h) ((4 + (b) * 2 + (h)) * HTB)
#define PG8_STAGE(bufoff, gbase, voff) do { _Pragma("unroll") for (int _i = 0; _i < 2; ++_i) \
        __builtin_amdgcn_global_load_lds((const unsigned*)((const char*)(gbase) + (voff)[_i]), (LAS unsigned*)(lds + (bufoff) + ldsw + _i * 8192), 16, 0, 0); } while (0)
#define PG8_LDA(dst, b, h) do { _Pragma("unroll") for (int m = 0; m < 4; ++m) _Pragma("unroll") for (int k = 0; k < 2; ++k) dst[m][k] = *(const LAS bf16x8*)(lds + PG8_SA(b, h) + aoff + m * 2048 + k * 1024); } while (0)
#define PG8_LDB(dst, b, h) do { _Pragma("unroll") for (int n = 0; n < 2; ++n) _Pragma("unroll") for (int k = 0; k < 2; ++k) dst[n][k] = *(const LAS bf16x8*)(lds + PG8_SB(b, h) + boff + n * 2048 + k * 1024); } while (0)
#define PG8_MMA(ai, bj, At, Bt) do { __builtin_amdgcn_s_setprio(1); _Pragma("unroll") for (int m = 0; m < 4; ++m) _Pragma("unroll") for (int n = 0; n < 2; ++n) _Pragma("unroll") for (int k = 0; k < 2; ++k) \
        acc[ai][bj][m][n] = __builtin_amdgcn_mfma_f32_16x16x32_bf16(Bt[n][k], At[m][k], acc[ai][bj][m][n], 0, 0, 0); __builtin_amdgcn_s_setprio(0); } while (0)
#define PG8_WAIT_V(n) asm volatile("s_waitcnt vmcnt(" #n ")" ::: "memory")
#define PG8_WAIT_L(n) asm volatile("s_waitcnt lgkmcnt(" #n ")" ::: "memory")
#define PG8_BAR __builtin_amdgcn_s_barrier()
#define PG8_SCHED __builtin_amdgcn_sched_barrier(0)
    Unit cur, nxt; int ui = 0;
    if (!S.next(0, cur)) return;
    f32x4 acc[2][2][4][2];
#pragma unroll
    for (int a = 0; a < 2; ++a)
#pragma unroll
        for (int b = 0; b < 2; ++b)
#pragma unroll
            for (int m = 0; m < 4; ++m)
#pragma unroll
                for (int n = 0; n < 2; ++n) acc[a][b][m][n] = (f32x4){0.f, 0.f, 0.f, 0.f};
    bf16x8 At[4][2], B0[2][2], B1[2][2];
    const char* cA = (const char*)g.A + (size_t)cur.pm * tstep; const char* cB = (const char*)g.Bt + (size_t)cur.pn * tstep;
    S.a_ready(cur);
    if constexpr (SP2) {
        PG8_STAGE(PG8_SB(0, 0), cB, voffB); PG8_STAGE(PG8_SB(0, 1), cB + hstep, voffB); PG8_STAGE(PG8_SA(0, 0), cA, voffA); PG8_STAGE(PG8_SA(0, 1), cA + hstep, voffA);
        if (wr == 1) PG8_BAR;
        PG8_WAIT_V(2); PG8_BAR;
        PG8_STAGE(PG8_SB(1, 0), cB + kstep, voffB); PG8_STAGE(PG8_SA(1, 0), cA + kstep, voffA); PG8_STAGE(PG8_SB(1, 1), cB + hstep + kstep, voffB);
        PG8_WAIT_V(6); PG8_BAR;
    } else {
        PG8_STAGE(PG8_SB(0, 0), cB, voffB); PG8_STAGE(PG8_SA(0, 0), cA, voffA); PG8_STAGE(PG8_SB(0, 1), cB + hstep, voffB); PG8_STAGE(PG8_SA(0, 1), cA + hstep, voffA);
        if (wr == 1) PG8_BAR;
        PG8_WAIT_V(4); PG8_BAR;
        PG8_STAGE(PG8_SB(1, 0), cB + kstep, voffB); PG8_STAGE(PG8_SA(1, 0), cA + kstep, voffA); PG8_STAGE(PG8_SB(1, 1), cB + hstep + kstep, voffB);
        PG8_WAIT_V(6); PG8_BAR;
    }
    for (;;) {
        const bool has_next = S.next(ui + 1, nxt);
        const char* nA = has_next ? (const char*)g.A + (size_t)nxt.pm * tstep : cA; const char* nB = has_next ? (const char*)g.Bt + (size_t)nxt.pn * tstep : cB;
        for (int t = 0; t < nt; t += 2) {
            const bool last = (t == nt - 2);
            const char* a1 = cA + (size_t)(t + 1) * kstep;
            const char* a2 = last ? nA : cA + (size_t)(t + 2) * kstep; const char* b2 = last ? nB : cB + (size_t)(t + 2) * kstep;
            const char* a3 = a2 + kstep; const char* b3 = b2 + kstep;
            if (last && has_next) S.a_ready(nxt);
            if constexpr (SP2) {
            PG8_LDB(B0, 0, 0); PG8_LDB(B1, 0, 1); PG8_SCHED; PG8_LDA(At, 0, 0); PG8_STAGE(PG8_SA(1, 1), a1 + hstep, voffA);
            PG8_WAIT_V(8); PG8_WAIT_L(0); PG8_BAR; PG8_MMA(0, 0, At, B0); PG8_MMA(0, 1, At, B1); PG8_BAR; PG8_SCHED;
            PG8_LDA(At, 0, 1); PG8_STAGE(PG8_SB(0, 0), b2, voffB); PG8_STAGE(PG8_SB(0, 1), b2 + hstep, voffB); PG8_STAGE(PG8_SA(0, 0), a2, voffA);
            PG8_WAIT_V(8); PG8_WAIT_L(0); PG8_BAR; PG8_MMA(1, 0, At, B0); PG8_MMA(1, 1, At, B1); PG8_BAR; PG8_SCHED;
            PG8_LDB(B0, 1, 0); PG8_LDB(B1, 1, 1); PG8_SCHED; PG8_LDA(At, 1, 0); PG8_STAGE(PG8_SA(0, 1), a2 + hstep, voffA);
            PG8_WAIT_V(8); PG8_WAIT_L(0); PG8_BAR; PG8_MMA(0, 0, At, B0); PG8_MMA(0, 1, At, B1); PG8_BAR; PG8_SCHED;
            PG8_LDA(At, 1, 1); PG8_STAGE(PG8_SB(1, 0), b3, voffB); PG8_STAGE(PG8_SB(1, 1), b3 + hstep, voffB); PG8_STAGE(PG8_SA(1, 0), a3, voffA);
            PG8_WAIT_V(8); PG8_WAIT_L(0); PG8_BAR; PG8_MMA(1, 0, At, B0); PG8_MMA(1, 1, At, B1); PG8_BAR; PG8_SCHED;
            } else {
            PG8_LDB(B0, 0, 0); PG8_SCHED; PG8_LDA(At, 0, 0); PG8_STAGE(PG8_SA(1, 1), a1 + hstep, voffA);
            PG8_WAIT_L(8); PG8_BAR; PG8_WAIT_L(0); PG8_MMA(0, 0, At, B0); PG8_BAR; PG8_SCHED;
            PG8_LDB(B1, 0, 1); PG8_STAGE(PG8_SB(0, 0), b2, voffB);
            PG8_BAR; PG8_WAIT_L(0); PG8_MMA(0, 1, At, B1); PG8_BAR;
            PG8_LDA(At, 0, 1); PG8_STAGE(PG8_SA(0, 0), a2, voffA);
            PG8_BAR; PG8_WAIT_L(0); PG8_MMA(1, 0, At, B0); PG8_BAR; PG8_SCHED;
            PG8_STAGE(PG8_SB(0, 1), b2 + hstep, voffB);
            PG8_WAIT_V(6); PG8_BAR; PG8_MMA(1, 1, At, B1); PG8_BAR;
            PG8_LDB(B0, 1, 0); PG8_SCHED; PG8_LDA(At, 1, 0); PG8_STAGE(PG8_SA(0, 1), a2 + hstep, voffA);
            PG8_WAIT_L(8); PG8_BAR; PG8_WAIT_L(0); PG8_MMA(0, 0, At, B0); PG8_BAR; PG8_SCHED;
            PG8_LDB(B1, 1, 1); PG8_STAGE(PG8_SB(1, 0), b3, voffB);
            PG8_BAR; PG8_WAIT_L(0); PG8_MMA(0, 1, At, B1); PG8_BAR;
            PG8_LDA(At, 1, 1); PG8_STAGE(PG8_SA(1, 0), a3, voffA);
            PG8_BAR; PG8_WAIT_L(0); PG8_MMA(1, 0, At, B0); PG8_BAR; PG8_SCHED;
            PG8_STAGE(PG8_SB(1, 1), b3 + hstep, voffB);
            PG8_WAIT_V(6); PG8_BAR; PG8_MMA(1, 1, At, B1); PG8_BAR;
            }
        }
        if constexpr (ALIGN_EPI) { if (wr == 0) PG8_BAR; }
        if constexpr (!Epi::AFTER_DRAIN) { E(acc, cur, wr, wc, fr, fq); S.done(cur); }
        if (!has_next) break;
#pragma unroll
        for (int a = 0; a < 2; ++a)
#pragma unroll
            for (int b = 0; b < 2; ++b)
#pragma unroll
                for (int m = 0; m < 4; ++m)
#pragma unroll
                    for (int n = 0; n < 2; ++n) acc[a][b][m][n] = (f32x4){0.f, 0.f, 0.f, 0.f};
        cur = nxt; cA = nA; cB = nB; ++ui;
        if constexpr (ALIGN_EPI) { if (wr == 1) PG8_BAR; }
    }
    PG8_WAIT_V(0);
    if constexpr (!ALIGN_EPI) { if (wr == 0) PG8_BAR; }
    PG8_BAR;
#undef PG8_SA
#undef PG8_SB
#undef PG8_STAGE
#undef PG8_LDA
#undef PG8_LDB
#undef PG8_MMA
#undef PG8_WAIT_V
#undef PG8_WAIT_L
#undef PG8_BAR
#undef PG8_SCHED
}
}

namespace att {
constexpr int KSTR = 528, VSTR = 576;
constexpr int L_K = 0, L_V = 64 * KSTR, L_O = 64 * KSTR + 64 * VSTR, OSTR = 1040, L_WS = L_O + 64 * OSTR, L_RPB = L_WS + 2048 + 512, L_CST = L_RPB + 7440 + 512, L_ALIBI = L_CST + 64, NAL = 416, L_END = L_ALIBI + 8 * NAL * 4;
constexpr int PITCH = INW;
#define MFMA32(a, b, c) __builtin_amdgcn_mfma_f32_32x32x16_bf16((a), (b), (c), 0, 0, 0)
typedef short v4i16_t __attribute__((ext_vector_type(4)));
DI s16x4 vtr(const LAS unsigned char* p) { return __builtin_bit_cast(s16x4, __builtin_amdgcn_ds_read_tr16_b64_v4i16((LAS v4i16_t*)p)); }

struct Args { const bf16_t* proj; const bf16_t* memkv; bf16_t* o; const float* sink; const float* rpb; const float* gains; int layer; };

template <int W> DI void tile_gload(u32x4 (&kr)[4], u32x4 (&vr)[4], const bf16_t* Kg, const bf16_t* Vg, int pitch, int tid) {
    constexpr int CPR = W / 8, NC = (64 * CPR) / 512;
#pragma unroll
    for (int c = 0; c < NC; ++c) { const int idx = tid + 512 * c, row = idx / CPR, ch = idx % CPR;
        kr[c] = *(const u32x4*)(Kg + (size_t)row * pitch + ch * 8); vr[c] = *(const u32x4*)(Vg + (size_t)row * pitch + ch * 8); }
}
template <int W> DI void tile_lstore(LAS unsigned char* lds, const u32x4 (&kr)[4], const u32x4 (&vr)[4], int tid) {
    constexpr int CPR = W / 8, NC = (64 * CPR) / 512;
#pragma unroll
    for (int c = 0; c < NC; ++c) { const int idx = tid + 512 * c, row = idx / CPR, ch = idx % CPR;
        *(LAS u32x4*)(lds + L_K + row * KSTR + ch * 16) = kr[c]; *(LAS u32x4*)(lds + L_V + row * VSTR + ch * 16) = vr[c]; }
}

template <int TYPE, int SUBS = 3> DI void tile_compute(LAS unsigned char* lds, const bf16x8 (&qf)[4], float& l, f32x16& o0, f32x16& o1,
                                         int hcolb, int lane, const LAS float* tab_lane, int e0, float negc) {
    const int r = lane & 31, h = lane >> 5;
    f32x16 p0, p1;
    if (TYPE == 2) {
#pragma unroll
        for (int i = 0; i < 16; ++i) { p0[i] = negc; p1[i] = negc; }
    } else {
#pragma unroll
        for (int i = 0; i < 16; ++i) { const int c = (i & 3) + 8 * (i >> 2); p0[i] = (SUBS & 1) ? tab_lane[c] : 0.f; p1[i] = (SUBS & 2) ? tab_lane[c + 32] : 0.f; }
    }
    const LAS unsigned char* kb = lds + L_K + r * KSTR + hcolb + 16 * h;
#pragma unroll
    for (int ds = 0; ds < 4; ++ds) {
        if (SUBS & 1) { const bf16x8 k0 = *(const LAS bf16x8*)(kb + ds * 32); p0 = MFMA32(k0, qf[ds], p0); }
        if (SUBS & 2) { const bf16x8 k1 = *(const LAS bf16x8*)(kb + 32 * KSTR + ds * 32); p1 = MFMA32(k1, qf[ds], p1); }
    }
    float sum = 0.f;
#pragma unroll
    for (int i = 0; i < 16; ++i) {
        if (SUBS & 1) { p0[i] = __builtin_amdgcn_exp2f(p0[i]); sum += p0[i]; }
        if (SUBS & 2) { p1[i] = __builtin_amdgcn_exp2f(p1[i]); sum += p1[i]; } }
    l += sum;
    bf16x8 pa[4];
#pragma unroll
    for (int s = 0; s < 2; ++s) {
        u32x4 w0, w1;
        w0.x = pk_bf16(p0[8 * s + 0], p0[8 * s + 1]); w0.y = pk_bf16(p0[8 * s + 2], p0[8 * s + 3]); w0.z = pk_bf16(p0[8 * s + 4], p0[8 * s + 5]); w0.w = pk_bf16(p0[8 * s + 6], p0[8 * s + 7]);
        w1.x = pk_bf16(p1[8 * s + 0], p1[8 * s + 1]); w1.y = pk_bf16(p1[8 * s + 2], p1[8 * s + 3]); w1.z = pk_bf16(p1[8 * s + 4], p1[8 * s + 5]); w1.w = pk_bf16(p1[8 * s + 6], p1[8 * s + 7]);
        pa[s] = __builtin_bit_cast(bf16x8, w0); pa[2 + s] = __builtin_bit_cast(bf16x8, w1);
    }
    const int i16 = lane & 15, q4 = i16 >> 2, pp = i16 & 3, blk = (lane >> 4) & 1;
    const LAS unsigned char* vb = lds + L_V + (4 * h + q4) * VSTR + hcolb + 32 * blk + 8 * pp;
#pragma unroll
    for (int s = 0; s < 4; ++s) {
        if (!((SUBS >> (s >> 1)) & 1)) continue;
        const s16x4 lo0 = vtr(vb + (16 * s) * VSTR), hi0 = vtr(vb + (16 * s + 8) * VSTR);
        const s16x4 lo1 = vtr(vb + (16 * s) * VSTR + 64), hi1 = vtr(vb + (16 * s + 8) * VSTR + 64);
        const bf16x8 v0 = __builtin_shufflevector(lo0, hi0, 0, 1, 2, 3, 4, 5, 6, 7), v1 = __builtin_shufflevector(lo1, hi1, 0, 1, 2, 3, 4, 5, 6, 7);
        o0 = MFMA32(pa[s], v0, o0); o1 = MFMA32(pa[s], v1, o1);
    }
}

template <int HALF> DI void tile_compute_b(LAS unsigned char* lds, const bf16x8 (&qf)[4], float& l, f32x16& o0, f32x16& o1,
                                           int hcolb, int lane, const LAS float* tab_lane, int e0) {
    const int r = lane & 31, h = lane >> 5;
    f32x16 p0, p1;
#pragma unroll
    for (int i = 0; i < 16; ++i) { const int c = (i & 3) + 8 * (i >> 2);
        p0[i] = (HALF == 0 || i >= 12) ? tab_lane[c] : 0.f; p1[i] = (HALF == 1 || i < 4) ? tab_lane[c + 32] : 0.f; }
    const LAS unsigned char* kb = lds + L_K + r * KSTR + hcolb + 16 * h;
#pragma unroll
    for (int ds = 0; ds < 4; ++ds) {
        const bf16x8 k0 = *(const LAS bf16x8*)(kb + ds * 32);
        const bf16x8 k1 = *(const LAS bf16x8*)(kb + 32 * KSTR + ds * 32);
        p0 = MFMA32(k0, qf[ds], p0); p1 = MFMA32(k1, qf[ds], p1);
    }
    float sum = 0.f;
#pragma unroll
    for (int i = 0; i < 16; ++i) { const int c = (i & 3) + 8 * (i >> 2);
        if (HALF == 0 || i >= 12) { p0[i] = __builtin_amdgcn_exp2f(((unsigned)(e0 + c) < 16u) ? p0[i] : -INFINITY); sum += p0[i]; } else p0[i] = 0.f;
        if (HALF == 1 || i < 4) { p1[i] = __builtin_amdgcn_exp2f(((unsigned)(e0 + c + 32) < 16u) ? p1[i] : -INFINITY); sum += p1[i]; } else p1[i] = 0.f; }
    l += sum;
    bf16x8 pa[4];
#pragma unroll
    for (int s = 0; s < 2; ++s) {
        u32x4 w0, w1;
        w0.x = pk_bf16(p0[8 * s + 0], p0[8 * s + 1]); w0.y = pk_bf16(p0[8 * s + 2], p0[8 * s + 3]); w0.z = pk_bf16(p0[8 * s + 4], p0[8 * s + 5]); w0.w = pk_bf16(p0[8 * s + 6], p0[8 * s + 7]);
        w1.x = pk_bf16(p1[8 * s + 0], p1[8 * s + 1]); w1.y = pk_bf16(p1[8 * s + 2], p1[8 * s + 3]); w1.z = pk_bf16(p1[8 * s + 4], p1[8 * s + 5]); w1.w = pk_bf16(p1[8 * s + 6], p1[8 * s + 7]);
        pa[s] = __builtin_bit_cast(bf16x8, w0); pa[2 + s] = __builtin_bit_cast(bf16x8, w1);
    }
    const int i16 = lane & 15, q4 = i16 >> 2, pp = i16 & 3, blk = (lane >> 4) & 1;
    const LAS unsigned char* vb = lds + L_V + (4 * h + q4) * VSTR + hcolb + 32 * blk + 8 * pp;
#pragma unroll
    for (int s = 0; s < 4; ++s) {
        if ((HALF == 0 && s == 3) || (HALF == 1 && s == 0)) continue;
        const s16x4 lo0 = vtr(vb + (16 * s) * VSTR), hi0 = vtr(vb + (16 * s + 8) * VSTR);
        const s16x4 lo1 = vtr(vb + (16 * s) * VSTR + 64), hi1 = vtr(vb + (16 * s + 8) * VSTR + 64);
        const bf16x8 v0 = __builtin_shufflevector(lo0, hi0, 0, 1, 2, 3, 4, 5, 6, 7), v1 = __builtin_shufflevector(lo1, hi1, 0, 1, 2, 3, 4, 5, 6, 7);
        o0 = MFMA32(pa[s], v0, o0); o1 = MFMA32(pa[s], v1, o1);
    }
}

DI void write_ost(LAS unsigned char* lds, LAS float* wsf, float l, const f32x16& o0, const f32x16& o1, int rt, int ocol, int lane) {
    const int r = lane & 31, h = lane >> 5;
    const float lt = l + __shfl_xor(l, 32);
    if (h == 0) wsf[r] = 1.0f / lt;
    asm volatile("s_waitcnt lgkmcnt(0)" ::: "memory");
#pragma unroll
    for (int g = 0; g < 4; ++g) { const f32x4 a = *(const LAS f32x4*)(wsf + 8 * g + 4 * h);
#pragma unroll
        for (int j = 0; j < 4; ++j) { const int i = 4 * g + j, row = 32 * rt + j + 8 * g + 4 * h;
            LAS bf16_t* op = (LAS bf16_t*)(lds + L_O + row * OSTR) + ocol + r;
            op[0] = (bf16_t)(pk_bf16(o0[i] * a[j], 0.f) & 0xffffu); op[32] = (bf16_t)(pk_bf16(o1[i] * a[j], 0.f) & 0xffffu); } }
    asm volatile("s_waitcnt lgkmcnt(0)" ::: "memory");
}
template <int NC> DI void finalize(LAS unsigned char* lds, bf16_t* o, int row0, int gcol, int tid) {
    __syncthreads();
    const int token = tid >> 3, c8 = tid & 7;
    u32x4 v[NC / 64]; float ss = 0.f;
#pragma unroll
    for (int j = 0; j < NC / 64; ++j) { v[j] = *(const LAS u32x4*)(lds + L_O + token * OSTR + (64 * j + 8 * c8) * 2);
#pragma unroll
        for (int e = 0; e < 4; ++e) { const float a = bf_lo(v[j][e]), b = bf_hi(v[j][e]); ss += a * a + b * b; } }
    ss += __shfl_xor(ss, 1); ss += __shfl_xor(ss, 2); ss += __shfl_xor(ss, 4);
    const float rstd = rsqrtf(ss * (1.0f / NC) + EPS);
#pragma unroll
    for (int j = 0; j < NC / 64; ++j) { u32x4 w;
#pragma unroll
        for (int e = 0; e < 4; ++e) w[e] = pk_bf16(bf_lo(v[j][e]) * rstd, bf_hi(v[j][e]) * rstd);
        *(u32x4*)(o + (size_t)(row0 + token) * DM + gcol + 64 * j + 8 * c8) = w; }
}

DI void load_q(bf16x8 (&qf)[4], const bf16_t* p) {
#pragma unroll
    for (int ds = 0; ds < 4; ++ds) qf[ds] = *(const bf16x8*)(p + 16 * ds);
}

DI void attn_unit(LAS unsigned char* lds, const Args& a, int u) {
    int tid_ = threadIdx.x; asm volatile("" : "+v"(tid_));
    const int tid = tid_, lane = tid & 63, wid = __builtin_amdgcn_readfirstlane(tid >> 6), r = lane & 31, h = lane >> 5;
    const int hg = wid >> 1, rt = wid & 1;
    const int row0 = u * 64;
    int S, seq_start, memrow0;
    if (row0 < NPROMPT) { S = 8192; const int b = row0 >> 13; seq_start = b << 13; memrow0 = b * 256; }
    else { S = 4096; const int b = (row0 - NPROMPT) >> 12; seq_start = NPROMPT + (b << 12); memrow0 = 2048 + b * 256; }
    const int pos0 = row0 - seq_start;
    const int R = S >> 6, rq = pos0 >> 6; int rstart = rq - 4; rstart = rstart < 0 ? 0 : rstart; rstart = rstart > R - 8 ? R - 8 : rstart;
    const bf16_t* projS = a.proj + (size_t)seq_start * PITCH;
    const bf16_t* qrow = a.proj + (size_t)(row0 + 32 * rt + r) * PITCH + 8 * h;
    LAS float* wsf = (LAS float*)(lds + L_WS) + wid * 64;
    const LAS float* rpbL = (const LAS float*)(lds + L_RPB);
    const bf16_t* memK = a.memkv + (size_t)memrow0 * DM + a.layer * 512;
    u32x4 kr[4], vr[4];
    bf16x8 qf[4]; float l; f32x16 o0, o1;
    const LAS float* cst = (const LAS float*)(lds + L_CST); const LAS float* alibiL = (const LAS float*)(lds + L_ALIBI);
#define GLOAD_A(kvh, t) do { const int tp_ = pos0 - 128 + 64 * (t); if (tp_ >= 0 && tp_ < S) tile_gload<64>(kr, vr, projS + (size_t)tp_ * PITCH + 512 + 64 * (kvh), projS + (size_t)tp_ * PITCH + 640 + 64 * (kvh), PITCH, tid); } while (0)
#define GLOAD_B(t) tile_gload<256>(kr, vr, projS + (size_t)(64 * (rstart + (t))) * PITCH + 1024, projS + (size_t)(64 * (rstart + (t))) * PITCH + 1280, PITCH, tid)
#define GLOAD_M(t) tile_gload<256>(kr, vr, memK + (size_t)(64 * (t)) * DM, memK + (size_t)(64 * (t)) * DM + 256, DM, tid)
#define ZERO_O() do { _Pragma("unroll") for (int i_ = 0; i_ < 16; ++i_) { o0[i_] = 0.f; o1[i_] = 0.f; } } while (0)
#define A_TP(t) (pos0 - 128 + 64 * (t))
#define A_OK(t) ((t) < 5 && A_TP(t) >= 0 && A_TP(t) < S)
#define A_GL(kvh, t, i) do { if (A_OK(t)) { const bf16_t* kp_ = projS + (size_t)A_TP(t) * PITCH + 512 + 64 * (kvh) + ((unsigned)tid >> 3) * (unsigned)PITCH + ((unsigned)tid & 7u) * 8u; \
        kr[i] = *(const u32x4*)kp_; vr[i] = *(const u32x4*)(kp_ + 128); } } while (0)
#define A_ST(i, cofs) do { LAS unsigned char* kd_ = lds + L_K + ((unsigned)tid >> 3) * KSTR + (cofs) + ((unsigned)tid & 7u) * 16; LAS unsigned char* vd_ = lds + L_V + ((unsigned)tid >> 3) * VSTR + (cofs) + ((unsigned)tid & 7u) * 16; \
        *(LAS u32x4*)kd_ = kr[i]; *(LAS u32x4*)vd_ = vr[i]; } while (0)
    A_GL(0, 0, 0); A_GL(0, 1, 1);
#pragma unroll 1
    for (int kvh = 0; kvh < 2; ++kvh) {
        const int head = 4 * kvh + hg;
        load_q(qf, qrow + 64 * head);
        { const float sink2 = a.sink[a.layer * 8 + head] * LOG2E; l = (h == 0) ? __builtin_amdgcn_exp2f(sink2 - fmaxf(cst[0], sink2)) : 0.0f; } ZERO_O();
        const LAS float* tl0 = alibiL + head * NAL + (4 * h - (pos0 + 32 * rt + r) + 192);
#pragma unroll 1
        for (int sp = 0; sp < 3; ++sp) {
            const int ta = 2 * sp, tb = 2 * sp + 1; const bool va = A_OK(ta), vb = A_OK(tb);
            if (va) A_ST(0, 0);
            if (vb) A_ST(1, 128);
            __syncthreads();
            if (sp < 2) { A_GL(kvh, ta + 2, 0); A_GL(kvh, tb + 2, 1); } else if (kvh == 0) { A_GL(1, 0, 0); A_GL(1, 1, 1); } else GLOAD_B(0);
            if (va) { const LAS float* tl = tl0 + A_TP(ta);
                if (ta == 4 && rt == 0) tile_compute<0, 1>(lds, qf, l, o0, o1, 0, lane, tl, 0, 0.f);
                else if (ta == 0 && rt == 1) tile_compute<0, 2>(lds, qf, l, o0, o1, 0, lane, tl, 0, 0.f);
                else tile_compute<0, 3>(lds, qf, l, o0, o1, 0, lane, tl, 0, 0.f); }
            if (vb) tile_compute<0, 3>(lds, qf, l, o0, o1, 128, lane, tl0 + A_TP(tb), 0, 0.f);
            __syncthreads();
        }
        write_ost(lds, wsf, l, o0, o1, rt, 64 * head, lane);
    }
#undef A_TP
#undef A_OK
#undef A_GL
#undef A_ST
    finalize<512>(lds, a.o, row0, 0, tid);
    {
        load_q(qf, qrow + 768 + 64 * hg);
        l = 0.f; ZERO_O();
        const int cq = 32 * rt + r; int cs = cq - 8; cs = cs < 0 ? 0 : cs; cs = cs > 48 ? 48 : cs;
        const int e0 = 4 * h - cs;
#pragma unroll 1
        for (int t = 0; t < 8; ++t) {
            tile_lstore<256>(lds, kr, vr, tid);
            __syncthreads();
            if (t < 7) GLOAD_B(t + 1); else GLOAD_M(0);
            const LAS float* rl = rpbL + hg * 465 + (rstart + t - rq + 7) * 31 + (4 * h - cq + 15);
            if (rt == 0) tile_compute_b<0>(lds, qf, l, o0, o1, 128 * hg, lane, rl, e0); else tile_compute_b<1>(lds, qf, l, o0, o1, 128 * hg, lane, rl, e0);
            __syncthreads();
        }
        write_ost(lds, wsf, l, o0, o1, rt, 64 * hg, lane);
    }
    finalize<256>(lds, a.o, row0, 512, tid);
    {
        load_q(qf, qrow + 1536 + 64 * hg);
        l = 0.f; ZERO_O();
        const float negcm = -cst[2];
#pragma unroll 1
        for (int t = 0; t < 4; ++t) {
            tile_lstore<256>(lds, kr, vr, tid);
            __syncthreads();
            if (t < 3) GLOAD_M(t + 1);
            tile_compute<2>(lds, qf, l, o0, o1, 128 * hg, lane, rpbL, 0, negcm);
            __syncthreads();
        }
        write_ost(lds, wsf, l, o0, o1, rt, 64 * hg, lane);
    }
    finalize<256>(lds, a.o, row0, 768, tid);
    __syncthreads();
#undef GLOAD_A
#undef GLOAD_B
#undef GLOAD_M
#undef ZERO_O
}

DI void attn_phase(LAS unsigned char* lds, const Args& a, int G, int bid) {
    int tid_ = threadIdx.x; asm volatile("" : "+v"(tid_)); const int tid = tid_;
    LAS float* rpbL = (LAS float*)(lds + L_RPB); LAS float* cst = (LAS float*)(lds + L_CST); LAS float* alibiL = (LAS float*)(lds + L_ALIBI);
    {
        const int wv = tid >> 6, ln = tid & 63;
        if (wv < 6) { float g = __builtin_fabsf(a.gains[wv * 64 + ln]);
#pragma unroll
            for (int o = 1; o < 64; o <<= 1) g = fmaxf(g, __shfl_xor(g, o));
            if (ln == 0) cst[8 + wv] = g; }
        __syncthreads();
        if (tid < 3) cst[tid] = 8.0f * LOG2E * cst[8 + 2 * tid] * cst[9 + 2 * tid];
        __syncthreads();
    }
    { const float cA = cst[0], cB = cst[1];
      for (int i = tid; i < 1860; i += 512) rpbL[i] = a.rpb[a.layer * 1860 + i] * LOG2E - cB;
      for (int i = tid; i < 8 * NAL; i += 512) { const int hh = i / NAL, d = i % NAL - 192, ad = d < 0 ? -d : d;
          const float sink2 = a.sink[a.layer * 8 + hh] * LOG2E, c2 = fmaxf(cA, sink2), slope2 = __builtin_amdgcn_exp2f(-(float)(hh + 1)) * LOG2E;
          alibiL[i] = (ad <= 128) ? -slope2 * (float)ad - c2 : -INFINITY; } }
    __syncthreads();
    const int nunits = NTOK / 64, upc = (nunits + G - 1) / G;
    const int vcu = (G % 8 == 0) ? (bid % 8) * (G / 8) + bid / 8 : bid;
    for (int i = 0; i < upc; ++i) { const int u = vcu * upc + i; if (u < nunits) attn_unit(lds, a, u); }
}
}

constexpr size_t MiB = 1u << 20;
constexpr size_t WS_WIN = 0, WS_WOUT = 7 * MiB, WS_WFF1 = 11 * MiB, WS_WFF2 = 27 * MiB, WS_WMEM = 43 * MiB, WS_MEMB = 45 * MiB, WS_MEMKV = 51 * MiB,
                 WS_STATS = 57 * MiB, WS_MSTATS = 62 * MiB, WS_CTL = 63 * MiB, WS_XB = 64 * MiB, WS_PROJ = 224 * MiB, WS_O = 504 * MiB, WS_HID = 224 * MiB, WS_STATS2 = 864 * MiB, WS_END = 869 * MiB;
constexpr int LDS_BYTES = 160 * 1024, LDS_BARW = LDS_BYTES - 64, CTL_BYTES = 16384;
static_assert(att::L_END <= LDS_BYTES && pg8::EPI_P + 8192 <= LDS_BYTES, "LDS map");

struct Params {
    const float *x_prompt, *x_sample, *mem_prompt, *mem_sample, *g_mix, *w_in, *qk_gain, *sink, *rpb, *o_gain, *w_out, *g_mem, *w_mem_kv, *g_ff, *w_ff1, *w_ff2;
    float* out; unsigned char* ws;
};

DI float wave_sum(float v) {
#pragma unroll
    for (int o = 1; o < 64; o <<= 1) v += __shfl_xor(v, o);
    return v;
}
DI void transpose_item(const float* W, const float* g, int K, int N, bf16_t* WT, LAS float* scr, int item, int lane) {
    const int nblk = N / 32, kb = item / nblk, nb = item % nblk, k0 = 64 * kb, n0 = 32 * nb;
    float wv[32];
#pragma unroll
    for (int i = 0; i < 32; ++i) { const int kk = 2 * i + (lane >> 5); wv[i] = W[(size_t)(k0 + kk) * N + n0 + (lane & 31)]; }
    const float gl = g ? g[k0 + lane] : 1.0f;
#pragma unroll
    for (int i = 0; i < 32; ++i) { const int kk = 2 * i + (lane >> 5); scr[kk * 33 + (lane & 31)] = wv[i] * __shfl(gl, kk); }
    asm volatile("s_waitcnt lgkmcnt(0)" ::: "memory");
    const int c = lane & 7;
#pragma unroll
    for (int j = 0; j < 4; ++j) { const int n = (lane >> 3) + 8 * j; const LAS float* s = scr + (8 * c) * 33 + n;
        u32x4 o; o.x = pk_bf16(s[0 * 33], s[1 * 33]); o.y = pk_bf16(s[2 * 33], s[3 * 33]); o.z = pk_bf16(s[4 * 33], s[5 * 33]); o.w = pk_bf16(s[6 * 33], s[7 * 33]);
        *(u32x4*)(WT + (size_t)(n0 + n) * K + k0 + 8 * c) = o; }
    asm volatile("s_waitcnt lgkmcnt(0)" ::: "memory");
}
DI void rows4_to_bf16(const float* xrow, bf16_t* orow, float* st, int lane) {
    f32x4 v[4][4]; float s[4];
#pragma unroll
    for (int r = 0; r < 4; ++r)
#pragma unroll
        for (int j = 0; j < 4; ++j) v[r][j] = *((const f32x4*)(xrow + (size_t)r * DM) + lane + 64 * j);
#pragma unroll
    for (int r = 0; r < 4; ++r) { s[r] = (dot4(v[r][0]) + dot4(v[r][1])) + (dot4(v[r][2]) + dot4(v[r][3])); }
#pragma unroll
    for (int o = 1; o < 64; o <<= 1) {
#pragma unroll
        for (int r = 0; r < 4; ++r) s[r] += __shfl_xor(s[r], o);
    }
#pragma unroll
    for (int r = 0; r < 4; ++r) {
        u32x2* o8 = (u32x2*)(orow + (size_t)r * DM) + lane;
#pragma unroll
        for (int j = 0; j < 4; ++j) { u32x2 w; w.x = pk_bf16(v[r][j][0], v[r][j][1]); w.y = pk_bf16(v[r][j][2], v[r][j][3]); o8[64 * j] = w; }
    }
    const float mine = (lane == 0) ? s[0] : (lane == 16) ? s[1] : (lane == 32) ? s[2] : (lane == 48) ? s[3] : 0.f;
    st[lane] = mine;
}
#define XB_TMO      128
#define XB_XCNT(j)  (256  + 64 * (j))
#define XB_XSUB(j)  (1280 + 64 * (j))
#define XB_XGEN(j)  (2304 + 64 * (j))
#define XB_TOP      3328
#define XB_TOPGEN   3392
#define XCD_BAR_WORDS 3456
#define XB_SPIN_CAP (1u << 18)
DI unsigned xb_ld(unsigned* p)              { return __hip_atomic_load(p, __ATOMIC_RELAXED, __HIP_MEMORY_SCOPE_AGENT); }
DI unsigned xb_add(unsigned* p, unsigned v) { return __hip_atomic_fetch_add(p, v, __ATOMIC_RELAXED, __HIP_MEMORY_SCOPE_AGENT); }
DI unsigned xb_xcc_id() { return (unsigned)__builtin_amdgcn_s_getreg((3 << 11) | 20) & 0xFu; }
#define XB_SPIN(cond, bar) do { unsigned _sp = 0; while (cond) { __builtin_amdgcn_s_sleep(1); \
    if ((++_sp & 255u) == 0u) { if (xb_ld(&(bar)[XB_TMO])) break; if (_sp > XB_SPIN_CAP) { atomicAdd(&(bar)[XB_TMO], 1u); break; } } } } while (0)
struct XcdBarrier { unsigned* bar; unsigned x; volatile LAS unsigned* st; };
DI XcdBarrier xcd_barrier_post(unsigned* bar, volatile LAS unsigned* st) {
    XcdBarrier b; b.bar = bar; b.x = xb_xcc_id(); b.st = st;
    if (threadIdx.x == 0) (void)xb_add(&bar[XB_XCNT(b.x)], 1u);
    return b;
}
DI void xcd_barrier_complete(unsigned* bar, unsigned x, unsigned& nloc, unsigned& nx) {
    const unsigned G = gridDim.x * gridDim.y * gridDim.z;
    unsigned sum, cnt, mine, sp = 0u;
    for (;;) {
        sum = 0u; cnt = 0u; mine = 0u;
#pragma unroll
        for (unsigned j = 0; j < 16; ++j) { const unsigned c = xb_ld(&bar[XB_XCNT(j)]); sum += c; cnt += (c > 0u) ? 1u : 0u; mine = (j == x) ? c : mine; }
        if (sum == G) break;
        __builtin_amdgcn_s_sleep(1);
        if ((++sp & 255u) == 0u) { if (xb_ld(&bar[XB_TMO])) break; if (sp > XB_SPIN_CAP) { atomicAdd(&bar[XB_TMO], 1u); break; } }
    }
    nloc = mine > 0u ? mine : 1u; nx = cnt > 0u ? cnt : 1u;
}
DI void xcd_barrier(const XcdBarrier& b) {
    asm volatile("s_waitcnt vmcnt(0)" ::: "memory");
    __syncthreads();
    if (threadIdx.x == 0) {
        unsigned* bar = b.bar;
        __builtin_amdgcn_s_waitcnt(0);
        unsigned nloc = b.st[0], nx = b.st[1];
        if (nloc == 0u) { xcd_barrier_complete(bar, b.x, nloc, nx); b.st[0] = nloc; b.st[1] = nx; }
        const unsigned old = xb_add(&bar[XB_XSUB(b.x)], 1u);
        const unsigned gen = old / nloc;
        if (old + 1u == (gen + 1u) * nloc) {
            __builtin_amdgcn_fence(__ATOMIC_RELEASE, "agent");
            asm volatile("s_waitcnt vmcnt(0)" ::: "memory");
            const unsigned og = xb_add(&bar[XB_TOP], 1u);
            const unsigned tg = og / nx;
            if (og + 1u == (tg + 1u) * nx) xb_add(&bar[XB_TOPGEN], 1u);
            else XB_SPIN(xb_ld(&bar[XB_TOPGEN]) == tg, bar);
            __builtin_amdgcn_fence(__ATOMIC_ACQUIRE, "agent");
            xb_add(&bar[XB_XGEN(b.x)], 1u);
            asm volatile("s_waitcnt vmcnt(0)" ::: "memory");
        } else {
            XB_SPIN(xb_ld(&bar[XB_XGEN(b.x)]) == gen, bar);
            __builtin_amdgcn_fence(__ATOMIC_ACQUIRE, "agent");
            asm volatile("s_waitcnt vmcnt(0)" ::: "memory");
        }
    }
    __syncthreads();
}

__global__ void __launch_bounds__(512, 2) fwd_megakernel(Params p) {
    extern __shared__ __attribute__((aligned(16))) unsigned char lds_raw[];
    LAS unsigned char* lds = (LAS unsigned char*)lds_raw;
    cg::grid_group grid = cg::this_grid();
    const int tid = threadIdx.x, lane = tid & 63, wave = __builtin_amdgcn_readfirstlane(tid >> 6);
    const int G = gridDim.x, bid = blockIdx.x;
    volatile LAS unsigned* barw = (volatile LAS unsigned*)(lds + LDS_BARW);
    if (tid < 2) barw[tid] = 0u;
    __syncthreads();
    XcdBarrier xbar = xcd_barrier_post((unsigned*)(p.ws + WS_CTL), barw);
    typedef const __attribute__((address_space(4))) Params* KP;
    KP kp0 = (KP)__builtin_amdgcn_kernarg_segment_ptr();
#define PHASE_PTRS() KP kp = kp0; asm volatile("" : "+s"(kp)); unsigned char* ws = kp->ws; \
    bf16_t* WIN = (bf16_t*)(ws + WS_WIN); bf16_t* WOUT = (bf16_t*)(ws + WS_WOUT); bf16_t* WFF1 = (bf16_t*)(ws + WS_WFF1); bf16_t* WFF2 = (bf16_t*)(ws + WS_WFF2); bf16_t* WMEM = (bf16_t*)(ws + WS_WMEM); \
    bf16_t* MEMB = (bf16_t*)(ws + WS_MEMB); bf16_t* MEMKV = (bf16_t*)(ws + WS_MEMKV); float* STATS = (float*)(ws + WS_STATS); float* STATS2 = (float*)(ws + WS_STATS2); float* MSTATS = (float*)(ws + WS_MSTATS); \
    bf16_t* XB = (bf16_t*)(ws + WS_XB); bf16_t* PROJ = (bf16_t*)(ws + WS_PROJ); bf16_t* OB = (bf16_t*)(ws + WS_O); bf16_t* HID = (bf16_t*)(ws + WS_HID); \
    (void)WIN; (void)WOUT; (void)WFF1; (void)WFF2; (void)WMEM; (void)MEMB; (void)MEMKV; (void)STATS; (void)STATS2; (void)MSTATS; (void)XB; (void)PROJ; (void)OB; (void)HID;

    {
        PHASE_PTRS();
        LAS float* scr = (LAS float*)(lds + wave * 16384);
        const int gw = bid * 8 + wave, NGW = G * 8;
        constexpr int I_IN = 16 * 56, I_OUT = 16 * 32, I_FF1 = 16 * 128, I_FF2 = 64 * 32, I_MEM = 16 * 16, I_L = I_IN + I_OUT + I_FF1 + I_FF2 + I_MEM;
        for (int it = gw; it < 2 * I_L; it += NGW) {
            const int l = it / I_L; int r = it % I_L;
            if (r < I_IN) { transpose_item(kp->w_in + (size_t)l * DM * INW, kp->g_mix + l * DM, DM, INW, WIN + (size_t)l * INW * DM, scr, r, lane); continue; } r -= I_IN;
            if (r < I_OUT) { transpose_item(kp->w_out + (size_t)l * DM * DM, kp->o_gain + l * DM, DM, DM, WOUT + (size_t)l * DM * DM, scr, r, lane); continue; } r -= I_OUT;
            if (r < I_FF1) { transpose_item(kp->w_ff1 + (size_t)l * DM * DFF, kp->g_ff + l * DM, DM, DFF, WFF1 + (size_t)l * DFF * DM, scr, r, lane); continue; } r -= I_FF1;
            if (r < I_FF2) { transpose_item(kp->w_ff2 + (size_t)l * DFF * DM, nullptr, DFF, DM, WFF2 + (size_t)l * DM * DFF, scr, r, lane); continue; } r -= I_FF2;
            transpose_item(kp->w_mem_kv + (size_t)l * DM * 512, kp->g_mem + l * DM, DM, 512, WMEM + (size_t)l * 512 * DM, scr, r, lane);
        }
        for (int m4 = gw; m4 < (NTOK + NMEMROWS) / 4; m4 += NGW) {
            const int m = m4 * 4;
            if (m < NTOK) { const float* src = (m < NPROMPT) ? kp->x_prompt + (size_t)m * DM : kp->x_sample + (size_t)(m - NPROMPT) * DM; rows4_to_bf16(src, XB + (size_t)m * DM, STATS + (size_t)m * 16, lane); }
            else { const int mm = m - NTOK; const float* src = (mm < 2048) ? kp->mem_prompt + (size_t)mm * DM : kp->mem_sample + (size_t)(mm - 2048) * DM; rows4_to_bf16(src, MEMB + (size_t)mm * DM, MSTATS + (size_t)mm * 16, lane); }
        }
    }
    grid.sync();

#pragma unroll 1
    for (int l = 0; l < 2; ++l) {
        {
            PHASE_PTRS();
            pg8::Gemm g{XB, WIN + (size_t)l * INW * DM, NTOK, INW, DM}; pg8::StaticOrder S; S.init(NTOK, INW, G, bid);
            pg8::EpiProj E{PROJ, INW, STATS, kp->qk_gain + l * 384, 0, lds};
            pg8::gemm_phase<pg8::EpiProj, pg8::StaticOrder, true, true>(lds, g, S, E);
            if (l == 0) {
                pg8::Gemm gm{MEMB, WMEM, NMEMROWS, 1024, DM}; pg8::StaticOrder Sm; Sm.init(NMEMROWS, 1024, G, (bid + 64) % G);
                pg8::EpiProj Em{MEMKV, 1024, MSTATS, kp->qk_gain, 1, lds};
                pg8::gemm_phase<pg8::EpiProj, pg8::StaticOrder, true, true>(lds, gm, Sm, Em);
            }
        }
        xcd_barrier(xbar);
        {
            PHASE_PTRS();
            att::Args a{PROJ, MEMKV, OB, kp->sink, kp->rpb, kp->qk_gain + l * 384, l};
            att::attn_phase(lds, a, G, bid);
        }
        xcd_barrier(xbar);
        {
            PHASE_PTRS();
            pg8::Gemm g{OB, WOUT + (size_t)l * DM * DM, NTOK, DM, DM}; pg8::StaticOrder S; S.init(NTOK, DM, G, bid);
            pg8::EpiRes E{XB, nullptr, nullptr, STATS2, lds};
            pg8::gemm_phase<pg8::EpiRes, pg8::StaticOrder, true, true>(lds, g, S, E);
        }
        xcd_barrier(xbar);
        {
            PHASE_PTRS();
            pg8::Gemm g{XB, WFF1 + (size_t)l * DFF * DM, NTOK, DFF, DM}; pg8::StaticOrder S; S.init(NTOK, DFF, G, bid);
            pg8::EpiFF1 E{HID};
            pg8::gemm_phase<pg8::EpiFF1, pg8::StaticOrder, true, true>(lds, g, S, E);
        }
        xcd_barrier(xbar);
        {
            PHASE_PTRS();
            pg8::Gemm g{HID, WFF2 + (size_t)l * DM * DFF, NTOK, DM, DFF}; pg8::StaticOrder S; S.init(NTOK, DM, G, bid);
            pg8::EpiRes E{XB, l == 1 ? kp->out : nullptr, STATS2, l == 1 ? nullptr : STATS, lds};
            pg8::gemm_phase<pg8::EpiRes, pg8::StaticOrder, true, true>(lds, g, S, E);
        }
        if (l == 0) xcd_barrier(xbar);
    }
}

extern "C" void kernel_launch(void* const* d_in, const int* in_sizes, int n_in, void* d_out, int out_size, void* d_ws, size_t ws_size, hipStream_t stream) {
    static int grid_blocks = 0;
    if (grid_blocks == 0) {
        if (n_in != 16 || out_size != NTOK * DM || ws_size < WS_END) { fprintf(stderr, "kernel_launch: unexpected shapes: n_in %d out %d ws %zu\n", n_in, out_size, ws_size); grid_blocks = -1; return; }
        int dev = 0, cus = 0, per_cu = 0;
        hipGetDevice(&dev);
        hipDeviceGetAttribute(&cus, hipDeviceAttributeMultiprocessorCount, dev);
        if (hipFuncSetAttribute((const void*)fwd_megakernel, hipFuncAttributeMaxDynamicSharedMemorySize, LDS_BYTES) != hipSuccess) { fprintf(stderr, "kernel_launch: hipFuncSetAttribute failed\n"); grid_blocks = -1; return; }
        if (hipOccupancyMaxActiveBlocksPerMultiprocessor(&per_cu, (const void*)fwd_megakernel, 512, LDS_BYTES) != hipSuccess || per_cu < 1) { fprintf(stderr, "kernel_launch: occupancy query gave %d\n", per_cu); per_cu = 1; }
        (void)hipGetLastError();
        grid_blocks = cus * 1;
    }
    if (grid_blocks < 0) return;
    Params p{};
    p.x_prompt = (const float*)d_in[0]; p.x_sample = (const float*)d_in[1]; p.mem_prompt = (const float*)d_in[2]; p.mem_sample = (const float*)d_in[3];
    p.g_mix = (const float*)d_in[4]; p.w_in = (const float*)d_in[5]; p.qk_gain = (const float*)d_in[6]; p.sink = (const float*)d_in[7]; p.rpb = (const float*)d_in[8];
    p.o_gain = (const float*)d_in[9]; p.w_out = (const float*)d_in[10]; p.g_mem = (const float*)d_in[11]; p.w_mem_kv = (const float*)d_in[12]; p.g_ff = (const float*)d_in[13];
    p.w_ff1 = (const float*)d_in[14]; p.w_ff2 = (const float*)d_in[15];
    p.out = (float*)d_out; p.ws = (unsigned char*)d_ws;
    if (hipMemsetAsync((char*)d_ws + WS_CTL, 0, CTL_BYTES, stream) != hipSuccess) { fprintf(stderr, "kernel_launch: hipMemsetAsync failed\n"); return; }
    void* args[] = {&p};
    hipError_t e = hipLaunchCooperativeKernel((const void*)fwd_megakernel, dim3(grid_blocks), dim3(512), args, LDS_BYTES, stream);
    if (e != hipSuccess) fprintf(stderr, "kernel_launch: cooperative launch failed: %s (grid %d)\n", hipGetErrorString(e), grid_blocks);
}
```

```cpp
#include <hip/hip_runtime.h>
#include <hip/hip_cooperative_groups.h>
#include <cstdio>
#include <cstdint>
namespace cg = cooperative_groups;

#define LAS __attribute__((address_space(3)))
#define DI __device__ __forceinline__
typedef unsigned short bf16_t;
typedef short bf16x8 __attribute__((ext_vector_type(8)));
typedef float f32x4 __attribute__((ext_vector_type(4)));
typedef float f32x16 __attribute__((ext_vector_type(16)));
typedef unsigned u32x4 __attribute__((ext_vector_type(4)));
typedef unsigned u32x2 __attribute__((ext_vector_type(2)));
typedef short s16x4 __attribute__((ext_vector_type(4)));

constexpr int DM = 1024, NTOK = 81920, NPROMPT = 65536, INW = 1792, DFF = 4096, NMEMROWS = 3072;
constexpr float EPS = 1e-6f, LOG2E = 1.4426950408889634f, QSCALE = 0.125f * 1.4426950408889634f;

DI unsigned pk_bf16(float lo, float hi) {
    typedef float f2 __attribute__((ext_vector_type(2))); typedef __bf16 b2 __attribute__((ext_vector_type(2)));
    f2 v = {lo, hi}; b2 o = __builtin_convertvector(v, b2); return __builtin_bit_cast(unsigned, o);
}
DI float dot4(f32x4 a) { return (a[0] * a[0] + a[1] * a[1]) + (a[2] * a[2] + a[3] * a[3]); }
DI float bf_lo(unsigned u) { return __uint_as_float(u << 16); }
DI float bf_hi(unsigned u) { return __uint_as_float(u & 0xffff0000u); }

namespace pg8 {
constexpr int BM = 256, BK = 64, HALF = 128, HTB = HALF * BK * 2, STAGE_BYTES = 8 * HTB, NXCD = 8, WGM = 8;
constexpr int EPI_RS = STAGE_BYTES, EPI_P = STAGE_BYTES + 1024;

__host__ __device__ __forceinline__ int lds_byte(int r, int c) { const int st = (r >> 4) * 2 + (c >> 5), rr = r & 15, cc = c & 31, ob = rr * 64 + cc * 2; return st * 1024 + (ob ^ (((ob >> 9) & 1) << 5)); }
__host__ __device__ __forceinline__ void stage_rc(int b, int& R, int& C) { const int st = b / 1024, sb = b % 1024, swz = sb ^ (((sb >> 9) & 1) << 5); R = (st >> 1) * 16 + swz / 64; C = (st & 1) * 32 + (swz % 64) / 2; }
__host__ __device__ __forceinline__ int perm32(int rho) { const int n = rho >> 4, i = rho & 15; return 8 * (i >> 2) + 4 * n + (i & 3); }

struct Unit { int pm, pn; };
struct Gemm { const bf16_t* A; const bf16_t* Bt; int M, N, K; };

struct StaticOrder {
    int nM, nN, nwg, G, c;
    __host__ __device__ void init(int M, int N, int G_, int c_) { nM = M / BM; nN = N / BM; nwg = nM * nN; G = G_; c = c_; }
    __host__ __device__ bool next(int i, Unit& u) const {
        const long L = (long)i * G + c; if (L >= nwg) return false;
        int wgid = (int)L; { const int q = nwg / NXCD, r = nwg % NXCD, xcd = wgid % NXCD, off = wgid / NXCD; wgid = (xcd < r ? xcd * (q + 1) : r * (q + 1) + (xcd - r) * q) + off; }
        const int nig = WGM * nN, gid = wgid / nig, fm = gid * WGM, gsz = (nM - fm) < WGM ? (nM - fm) : WGM;
        u.pm = fm + ((wgid % nig) % gsz); u.pn = (wgid % nig) / gsz; return true;
    }
    __device__ __forceinline__ void a_ready(const Unit&) const {}
    __device__ __forceinline__ void done(const Unit&) const {}
};


DI void stage_rstd(LAS unsigned char* lds0, const float* stats, int row0) {
    int tid = threadIdx.x; asm volatile("" : "+v"(tid));
    const f32x4* q = (const f32x4*)(stats + (size_t)(row0 + (tid >> 1)) * 16 + (tid & 1) * 8); const f32x4 a = q[0], b = q[1];
    float s = ((a[0] + a[1]) + (a[2] + a[3])) + ((b[0] + b[1]) + (b[2] + b[3]));
    s += __shfl_xor(s, 1);
    if ((tid & 1) == 0) ((LAS float*)(lds0 + EPI_RS))[tid >> 1] = rsqrtf(s * (1.0f / 1024.0f) + EPS);
}
#define EPI_BARRIER() do { asm volatile("s_waitcnt lgkmcnt(0)" ::: "memory"); __builtin_amdgcn_s_barrier(); asm volatile("" ::: "memory"); } while (0)

DI u32x4 xpose_fwd(u32x4 w, int lane) { const int src = ((((lane & 3) << 4) | (lane >> 2)) << 2); u32x4 o;
    o.x = (unsigned)__builtin_amdgcn_ds_bpermute(src, (int)w.x); o.y = (unsigned)__builtin_amdgcn_ds_bpermute(src, (int)w.y); o.z = (unsigned)__builtin_amdgcn_ds_bpermute(src, (int)w.z); o.w = (unsigned)__builtin_amdgcn_ds_bpermute(src, (int)w.w); return o; }
DI u32x4 xpose_inv(u32x4 w, int lane) { const int src = ((((lane & 15) << 2) | (lane >> 4)) << 2); u32x4 o;
    o.x = (unsigned)__builtin_amdgcn_ds_bpermute(src, (int)w.x); o.y = (unsigned)__builtin_amdgcn_ds_bpermute(src, (int)w.y); o.z = (unsigned)__builtin_amdgcn_ds_bpermute(src, (int)w.z); o.w = (unsigned)__builtin_amdgcn_ds_bpermute(src, (int)w.w); return o; }

struct EpiProj {
    static constexpr bool PERM = true, AFTER_DRAIN = false;
    bf16_t* O; int ldc; const float* stats; const float* gains; int mode; LAS unsigned char* lds0;
    DI void cfg(int pn, int bj, int& gi, float& mult) const {
        gi = -1; mult = 1.f;
        if (mode == 0) {
            if (pn <= 1) { gi = 0; mult = QSCALE; }
            else if (pn == 2) { if (bj == 0) gi = 1; }
            else if (pn == 3) { gi = 2; mult = QSCALE; }
            else if (pn == 4) { gi = 3; }
            else if (pn == 6) { gi = 4; mult = QSCALE; }
        } else { if (pn == 0) gi = 5; else if (pn == 2) gi = 11; }
    }
    DI void operator()(const f32x4 (&acc)[2][2][4][2], const Unit& u, int wr, int wc, int fr, int fq) const {
        stage_rstd(lds0, stats, u.pm * BM);
        LAS float* P = (LAS float*)(lds0 + EPI_P); const LAS float* rs = (const LAS float*)(lds0 + EPI_RS);
#pragma unroll
        for (int ai = 0; ai < 2; ++ai)
#pragma unroll
            for (int m = 0; m < 4; ++m)
#pragma unroll
                for (int bj = 0; bj < 2; ++bj) {
                    float s = dot4(acc[ai][bj][m][0]) + dot4(acc[ai][bj][m][1]);
                    s += __shfl_xor(s, 16); s += __shfl_xor(s, 32);
                    if (fq == 0) P[(bj * 256 + ai * HALF + wr * 64 + m * 16 + fr) * 4 + wc] = s;
                }
        EPI_BARRIER();
#pragma unroll
        for (int bj = 0; bj < 2; ++bj) {
            int gi; float mult; cfg(u.pn, bj, gi, mult);
            f32x4 g0 = {1.f, 1.f, 1.f, 1.f}, g1 = {1.f, 1.f, 1.f, 1.f};
            if (gi >= 0) { const float* gp = gains + gi * 64 + (wc & 1) * 32 + 8 * fq; g0 = *(const f32x4*)gp; g1 = *(const f32x4*)(gp + 4); }
#pragma unroll
            for (int ai = 0; ai < 2; ++ai)
#pragma unroll
                for (int m = 0; m < 4; ++m) {
                    const int rl = ai * HALF + wr * 64 + m * 16 + fr; const float rstd = rs[rl]; float sc = rstd;
                    if (gi >= 0) { const int pi = (bj * 256 + rl) * 4 + (wc & 2); const float tot = P[pi] + P[pi + 1]; sc = rstd * rsqrtf(tot * rstd * rstd * (1.0f / 64.0f) + EPS) * mult; }
                    const f32x4 v0 = acc[ai][bj][m][0] * sc * g0, v1 = acc[ai][bj][m][1] * sc * g1;
                    u32x4 w; w.x = pk_bf16(v0[0], v0[1]); w.y = pk_bf16(v0[2], v0[3]); w.z = pk_bf16(v1[0], v1[1]); w.w = pk_bf16(v1[2], v1[3]);
                    { const int ln = fq * 16 + fr; *(u32x4*)(O + (size_t)(u.pm * BM + rl - fr + (ln >> 2)) * ldc + u.pn * BM + bj * HALF + wc * 32 + 8 * (ln & 3)) = xpose_fwd(w, ln); }
                    if (m & 1) asm volatile("" ::: "memory");
                }
        }
    }
};

struct EpiRes {
    static constexpr bool PERM = true, AFTER_DRAIN = false;
    bf16_t* xb; float* outf; const float* rstats; float* wstats; LAS unsigned char* lds0;
    DI void operator()(const f32x4 (&acc)[2][2][4][2], const Unit& u, int wr, int wc, int fr, int fq) const {
        const LAS float* rs = (const LAS float*)(lds0 + EPI_RS);
        if (rstats) { stage_rstd(lds0, rstats, u.pm * BM); EPI_BARRIER(); }
        const int col0 = u.pn * BM + wc * 32 + 8 * fq;
#pragma unroll
        for (int ai = 0; ai < 2; ++ai)
#pragma unroll
            for (int m = 0; m < 4; ++m) {
                const int rl = ai * HALF + wr * 64 + m * 16 + fr; const size_t grow = (size_t)(u.pm * BM + rl);
                float sc = 1.0f; if (rstats) { const float r_ = rs[rl]; sc = r_ * r_; }
                float ss = 0.f;
#pragma unroll
                for (int bj = 0; bj < 2; ++bj) {
                    const int c = col0 + bj * HALF;
                    const int ln = fq * 16 + fr; const size_t grow2 = grow - fr + (ln >> 2); const int c2 = u.pn * BM + wc * 32 + bj * HALF + 8 * (ln & 3);
                    const u32x4 b = xpose_inv(*(const u32x4*)(xb + grow2 * DM + c2), ln);
                    const f32x4 b0 = {bf_lo(b.x), bf_hi(b.x), bf_lo(b.y), bf_hi(b.y)}, b1 = {bf_lo(b.z), bf_hi(b.z), bf_lo(b.w), bf_hi(b.w)};
                    const f32x4 v0 = acc[ai][bj][m][0] * sc + b0, v1 = acc[ai][bj][m][1] * sc + b1;
                    if (outf) { const u32x4 t0 = xpose_fwd(__builtin_bit_cast(u32x4, v0), ln), t1 = xpose_fwd(__builtin_bit_cast(u32x4, v1), ln);
                                *(u32x4*)(outf + grow2 * DM + c2) = t0; *(u32x4*)(outf + grow2 * DM + c2 + 4) = t1; }
                    else { u32x4 w; w.x = pk_bf16(v0[0], v0[1]); w.y = pk_bf16(v0[2], v0[3]); w.z = pk_bf16(v1[0], v1[1]); w.w = pk_bf16(v1[2], v1[3]); *(u32x4*)(xb + grow2 * DM + c2) = xpose_fwd(w, ln); }
                    ss += dot4(v0) + dot4(v1);
                }
                if (!outf) { ss += __shfl_xor(ss, 16); ss += __shfl_xor(ss, 32); if (fq == 0) wstats[grow * 16 + u.pn * 4 + wc] = ss; }
                if (m & 1) asm volatile("" ::: "memory");
            }
    }
};

struct EpiFF1 {
    static constexpr bool PERM = true, AFTER_DRAIN = false;
    bf16_t* O;
    DI void operator()(const f32x4 (&acc)[2][2][4][2], const Unit& u, int wr, int wc, int fr, int fq) const {
#pragma unroll
        for (int ai = 0; ai < 2; ++ai)
#pragma unroll
            for (int m = 0; m < 4; ++m) {
                const int rl = ai * HALF + wr * 64 + m * 16 + fr;
#pragma unroll
                for (int bj = 0; bj < 2; ++bj) {
                    f32x4 v0 = acc[ai][bj][m][0], v1 = acc[ai][bj][m][1];
#pragma unroll
                    for (int e = 0; e < 4; ++e) { const float a = fmaxf(v0[e], 0.f), b = fmaxf(v1[e], 0.f); v0[e] = a * a; v1[e] = b * b; }
                    u32x4 w; w.x = pk_bf16(v0[0], v0[1]); w.y = pk_bf16(v0[2], v0[3]); w.z = pk_bf16(v1[0], v1[1]); w.w = pk_bf16(v1[2], v1[3]);
                    { const int ln = fq * 16 + fr; __builtin_nontemporal_store(xpose_fwd(w, ln), (u32x4*)(O + (size_t)(u.pm * BM + rl - fr + (ln >> 2)) * DFF + u.pn * BM + bj * HALF + wc * 32 + 8 * (ln & 3))); }
                }
            }
    }
};

template <class Epi, class Sched, bool ALIGN_EPI = false, bool SP2 = false>
__device__ __forceinline__ void gemm_phase(LAS unsigned char* lds, const Gemm g, const Sched& S, const Epi& E) {
    int tid_ = threadIdx.x; asm volatile("" : "+v"(tid_));
    const int tid = tid_, wid = __builtin_amdgcn_readfirstlane(tid >> 6), lane = tid & 63, wr = wid >> 2, wc = wid & 3, fr = lane & 15, fq = lane >> 4;
    const int K = g.K, nt = K / BK;
    unsigned voffA[2], voffB[2];
#pragma unroll
    for (int i = 0; i < 2; ++i) { int R, C; stage_rc(tid * 16 + i * 8192, R, C); const int Rb = Epi::PERM ? ((R & ~31) + perm32(R & 31)) : R;
        voffA[i] = (unsigned)(R * K + C) * 2u; voffB[i] = (unsigned)(Rb * K + C) * 2u; }
    const size_t kstep = (size_t)(BK * 2);
    const size_t hstep = (size_t)HALF * K * 2;
    const size_t tstep = 2 * hstep;
    const unsigned ldsw = (unsigned)wid * 1024u;
    const int aoff = lds_byte(wr * 64 + fr, fq * 8), boff = lds_byte(wc * 32 + fr, fq * 8);
#define PG8_SA(b, h) (((b) * 2 + (h)) * HTB)
#define PG8_SB(b, h) ((4 + (b) * 2 + (h)) * HTB)
#define PG8_STAGE(bufoff, gbase, voff) do { _Pragma("unroll") for (int _i = 0; _i < 2; ++_i) \
        __builtin_amdgcn_global_load_lds((const unsigned*)((const char*)(gbase) + (voff)[_i]), (LAS unsigned*)(lds + (bufoff) + ldsw + _i * 8192), 16, 0, 0); } while (0)
#define PG8_LDA(dst, b, h) do { _Pragma("unroll") for (int m = 0; m < 4; ++m) _Pragma("unroll") for (int k = 0; k < 2; ++k) dst[m][k] = *(const LAS bf16x8*)(lds + PG8_SA(b, h) + aoff + m * 2048 + k * 1024); } while (0)
#define PG8_LDB(dst, b, h) do { _Pragma("unroll") for (int n = 0; n < 2; ++n) _Pragma("unroll") for (int k = 0; k < 2; ++k) dst[n][k] = *(const LAS bf16x8*)(lds + PG8_SB(b, h) + boff + n * 2048 + k * 1024); } while (0)
#define PG8_MMA(ai, bj, At, Bt) do { __builtin_amdgcn_s_setprio(1); _Pragma("unroll") for (int m = 0; m < 4; ++m) _Pragma("unroll") for (int n = 0; n < 2; ++n) _Pragma("unroll") for (int k = 0; k < 2; ++k) \
        acc[ai][bj][m][n] = __builtin_amdgcn_mfma_f32_16x16x32_bf16(Bt[n][k], At[m][k], acc[ai][bj][m][n], 0, 0, 0); __builtin_amdgcn_s_setprio(0); } while (0)
#define PG8_WAIT_V(n) asm volatile("s_waitcnt vmcnt(" #n ")" ::: "memory")
#define PG8_WAIT_L(n) asm volatile("s_waitcnt lgkmcnt(" #n ")" ::: "memory")
#define PG8_BAR __builtin_amdgcn_s_barrier()
#define PG8_SCHED __builtin_amdgcn_sched_barrier(0)
    Unit cur, nxt; int ui = 0;
    if (!S.next(0, cur)) return;
    f32x4 acc[2][2][4][2];
#pragma unroll
    for (int a = 0; a < 2; ++a)
#pragma unroll
        for (int b = 0; b < 2; ++b)
#pragma unroll
            for (int m = 0; m < 4; ++m)
#pragma unroll
                for (int n = 0; n < 2; ++n) acc[a][b][m][n] = (f32x4){0.f, 0.f, 0.f, 0.f};
    bf16x8 At[4][2], B0[2][2], B1[2][2];
    const char* cA = (const char*)g.A + (size_t)cur.pm * tstep; const char* cB = (const char*)g.Bt + (size_t)cur.pn * tstep;
    S.a_ready(cur);
    if constexpr (SP2) {
        PG8_STAGE(PG8_SB(0, 0), cB, voffB); PG8_STAGE(PG8_SB(0, 1), cB + hstep, voffB); PG8_STAGE(PG8_SA(0, 0), cA, voffA); PG8_STAGE(PG8_SA(0, 1), cA + hstep, voffA);
        if (wr == 1) PG8_BAR;
        PG8_WAIT_V(2); PG8_BAR;
        PG8_STAGE(PG8_SB(1, 0), cB + kstep, voffB); PG8_STAGE(PG8_SA(1, 0), cA + kstep, voffA); PG8_STAGE(PG8_SB(1, 1), cB + hstep + kstep, voffB);
        PG8_WAIT_V(6); PG8_BAR;
    } else {
        PG8_STAGE(PG8_SB(0, 0), cB, voffB); PG8_STAGE(PG8_SA(0, 0), cA, voffA); PG8_STAGE(PG8_SB(0, 1), cB + hstep, voffB); PG8_STAGE(PG8_SA(0, 1), cA + hstep, voffA);
        if (wr == 1) PG8_BAR;
        PG8_WAIT_V(4); PG8_BAR;
        PG8_STAGE(PG8_SB(1, 0), cB + kstep, voffB); PG8_STAGE(PG8_SA(1, 0), cA + kstep, voffA); PG8_STAGE(PG8_SB(1, 1), cB + hstep + kstep, voffB);
        PG8_WAIT_V(6); PG8_BAR;
    }
    for (;;) {
        const bool has_next = S.next(ui + 1, nxt);
        const char* nA = has_next ? (const char*)g.A + (size_t)nxt.pm * tstep : cA; const char* nB = has_next ? (const char*)g.Bt + (size_t)nxt.pn * tstep : cB;
        for (int t = 0; t < nt; t += 2) {
            const bool last = (t == nt - 2);
            const char* a1 = cA + (size_t)(t + 1) * kstep;
            const char* a2 = last ? nA : cA + (size_t)(t + 2) * kstep; const char* b2 = last ? nB : cB + (size_t)(t + 2) * kstep;
            const char* a3 = a2 + kstep; const char* b3 = b2 + kstep;
            if (last && has_next) S.a_ready(nxt);
            if constexpr (SP2) {
            PG8_LDB(B0, 0, 0); PG8_LDB(B1, 0, 1); PG8_SCHED; PG8_LDA(At, 0, 0); PG8_STAGE(PG8_SA(1, 1), a1 + hstep, voffA);
            PG8_WAIT_V(8); PG8_WAIT_L(0); PG8_BAR; PG8_MMA(0, 0, At, B0); PG8_MMA(0, 1, At, B1); PG8_BAR; PG8_SCHED;
            PG8_LDA(At, 0, 1); PG8_STAGE(PG8_SB(0, 0), b2, voffB); PG8_STAGE(PG8_SB(0, 1), b2 + hstep, voffB); PG8_STAGE(PG8_SA(0, 0), a2, voffA);
            PG8_WAIT_V(8); PG8_WAIT_L(0); PG8_BAR; PG8_MMA(1, 0, At, B0); PG8_MMA(1, 1, At, B1); PG8_BAR; PG8_SCHED;
            PG8_LDB(B0, 1, 0); PG8_LDB(B1, 1, 1); PG8_SCHED; PG8_LDA(At, 1, 0); PG8_STAGE(PG8_SA(0, 1), a2 + hstep, voffA);
            PG8_WAIT_V(8); PG8_WAIT_L(0); PG8_BAR; PG8_MMA(0, 0, At, B0); PG8_MMA(0, 1, At, B1); PG8_BAR; PG8_SCHED;
            PG8_LDA(At, 1, 1); PG8_STAGE(PG8_SB(1, 0), b3, voffB); PG8_STAGE(PG8_SB(1, 1), b3 + hstep, voffB); PG8_STAGE(PG8_SA(1, 0), a3, voffA);
            PG8_WAIT_V(8); PG8_WAIT_L(0); PG8_BAR; PG8_MMA(1, 0, At, B0); PG8_MMA(1, 1, At, B1); PG8_BAR; PG8_SCHED;
            } else {
            PG8_LDB(B0, 0, 0); PG8_SCHED; PG8_LDA(At, 0, 0); PG8_STAGE(PG8_SA(1, 1), a1 + hstep, voffA);
            PG8_WAIT_L(8); PG8_BAR; PG8_WAIT_L(0); PG8_MMA(0, 0, At, B0); PG8_BAR; PG8_SCHED;
            PG8_LDB(B1, 0, 1); PG8_STAGE(PG8_SB(0, 0), b2, voffB);
            PG8_BAR; PG8_WAIT_L(0); PG8_MMA(0, 1, At, B1); PG8_BAR;
            PG8_LDA(At, 0, 1); PG8_STAGE(PG8_SA(0, 0), a2, voffA);
            PG8_BAR; PG8_WAIT_L(0); PG8_MMA(1, 0, At, B0); PG8_BAR; PG8_SCHED;
            PG8_STAGE(PG8_SB(0, 1), b2 + hstep, voffB);
            PG8_WAIT_V(6); PG8_BAR; PG8_MMA(1, 1, At, B1); PG8_BAR;
            PG8_LDB(B0, 1, 0); PG8_SCHED; PG8_LDA(At, 1, 0); PG8_STAGE(PG8_SA(0, 1), a2 + hstep, voffA);
            PG8_WAIT_L(8); PG8_BAR; PG8_WAIT_L(0); PG8_MMA(0, 0, At, B0); PG8_BAR; PG8_SCHED;
            PG8_LDB(B1, 1, 1); PG8_STAGE(PG8_SB(1, 0), b3, voffB);
            PG8_BAR; PG8_WAIT_L(0); PG8_MMA(0, 1, At, B1); PG8_BAR;
            PG8_LDA(At, 1, 1); PG8_STAGE(PG8_SA(1, 0), a3, voffA);
            PG8_BAR; PG8_WAIT_L(0); PG8_MMA(1, 0, At, B0); PG8_BAR; PG8_SCHED;
            PG8_STAGE(PG8_SB(1, 1), b3 + hstep, voffB);
            PG8_WAIT_V(6); PG8_BAR; PG8_MMA(1, 1, At, B1); PG8_BAR;
            }
        }
        if constexpr (ALIGN_EPI) { if (wr == 0) PG8_BAR; }
        if constexpr (!Epi::AFTER_DRAIN) { E(acc, cur, wr, wc, fr, fq); S.done(cur); }
        if (!has_next) break;
#pragma unroll
        for (int a = 0; a < 2; ++a)
#pragma unroll
            for (int b = 0; b < 2; ++b)
#pragma unroll
                for (int m = 0; m < 4; ++m)
#pragma unroll
                    for (int n = 0; n < 2; ++n) acc[a][b][m][n] = (f32x4){0.f, 0.f, 0.f, 0.f};
        cur = nxt; cA = nA; cB = nB; ++ui;
        if constexpr (ALIGN_EPI) { if (wr == 1) PG8_BAR; }
    }
    PG8_WAIT_V(0);
    if constexpr (!ALIGN_EPI) { if (wr == 0) PG8_BAR; }
    PG8_BAR;
#undef PG8_SA
#undef PG8_SB
#undef PG8_STAGE
#undef PG8_LDA
#undef PG8_LDB
#undef PG8_MMA
#undef PG8_WAIT_V
#undef PG8_WAIT_L
#undef PG8_BAR
#undef PG8_SCHED
}
}

namespace att {
constexpr int KSTR = 528, VSTR = 576;
constexpr int L_K = 0, L_V = 64 * KSTR, L_O = 64 * KSTR + 64 * VSTR, OSTR = 1040, L_WS = L_O + 64 * OSTR, L_RPB = L_WS + 2048 + 512, L_CST = L_RPB + 7440 + 512, L_ALIBI = L_CST + 64, NAL = 416, L_END = L_ALIBI + 8 * NAL * 4;
constexpr int PITCH = INW;
#define MFMA32(a, b, c) __builtin_amdgcn_mfma_f32_32x32x16_bf16((a), (b), (c), 0, 0, 0)
typedef short v4i16_t __attribute__((ext_vector_type(4)));
DI s16x4 vtr(const LAS unsigned char* p) { return __builtin_bit_cast(s16x4, __builtin_amdgcn_ds_read_tr16_b64_v4i16((LAS v4i16_t*)p)); }

struct Args { const bf16_t* proj; const bf16_t* memkv; bf16_t* o; const float* sink; const float* rpb; const float* gains; int layer; };

template <int W> DI void tile_gload(u32x4 (&kr)[4], u32x4 (&vr)[4], const bf16_t* Kg, const bf16_t* Vg, int pitch, int tid) {
    constexpr int CPR = W / 8, NC = (64 * CPR) / 512;
#pragma unroll
    for (int c = 0; c < NC; ++c) { const int idx = tid + 512 * c, row = idx / CPR, ch = idx % CPR;
        kr[c] = *(const u32x4*)(Kg + (size_t)row * pitch + ch * 8); vr[c] = *(const u32x4*)(Vg + (size_t)row * pitch + ch * 8); }
}
template <int W> DI void tile_lstore(LAS unsigned char* lds, const u32x4 (&kr)[4], const u32x4 (&vr)[4], int tid) {
    constexpr int CPR = W / 8, NC = (64 * CPR) / 512;
#pragma unroll
    for (int c = 0; c < NC; ++c) { const int idx = tid + 512 * c, row = idx / CPR, ch = idx % CPR;
        *(LAS u32x4*)(lds + L_K + row * KSTR + ch * 16) = kr[c]; *(LAS u32x4*)(lds + L_V + row * VSTR + ch * 16) = vr[c]; }
}

template <int TYPE, int SUBS = 3> DI void tile_compute(LAS unsigned char* lds, const bf16x8 (&qf)[4], float& l, f32x16& o0, f32x16& o1,
                                         int hcolb, int lane, const LAS float* tab_lane, int e0, float negc) {
    const int r = lane & 31, h = lane >> 5;
    f32x16 p0, p1;
    if (TYPE == 2) {
#pragma unroll
        for (int i = 0; i < 16; ++i) { p0[i] = negc; p1[i] = negc; }
    } else {
#pragma unroll
        for (int i = 0; i < 16; ++i) { const int c = (i & 3) + 8 * (i >> 2); p0[i] = (SUBS & 1) ? tab_lane[c] : 0.f; p1[i] = (SUBS & 2) ? tab_lane[c + 32] : 0.f; }
    }
    const LAS unsigned char* kb = lds + L_K + r * KSTR + hcolb + 16 * h;
#pragma unroll
    for (int ds = 0; ds < 4; ++ds) {
        if (SUBS & 1) { const bf16x8 k0 = *(const LAS bf16x8*)(kb + ds * 32); p0 = MFMA32(k0, qf[ds], p0); }
        if (SUBS & 2) { const bf16x8 k1 = *(const LAS bf16x8*)(kb + 32 * KSTR + ds * 32); p1 = MFMA32(k1, qf[ds], p1); }
    }
    float sum = 0.f;
#pragma unroll
    for (int i = 0; i < 16; ++i) {
        if (SUBS & 1) { p0[i] = __builtin_amdgcn_exp2f(p0[i]); sum += p0[i]; }
        if (SUBS & 2) { p1[i] = __builtin_amdgcn_exp2f(p1[i]); sum += p1[i]; } }
    l += sum;
    bf16x8 pa[4];
#pragma unroll
    for (int s = 0; s < 2; ++s) {
        u32x4 w0, w1;
        w0.x = pk_bf16(p0[8 * s + 0], p0[8 * s + 1]); w0.y = pk_bf16(p0[8 * s + 2], p0[8 * s + 3]); w0.z = pk_bf16(p0[8 * s + 4], p0[8 * s + 5]); w0.w = pk_bf16(p0[8 * s + 6], p0[8 * s + 7]);
        w1.x = pk_bf16(p1[8 * s + 0], p1[8 * s + 1]); w1.y = pk_bf16(p1[8 * s + 2], p1[8 * s + 3]); w1.z = pk_bf16(p1[8 * s + 4], p1[8 * s + 5]); w1.w = pk_bf16(p1[8 * s + 6], p1[8 * s + 7]);
        pa[s] = __builtin_bit_cast(bf16x8, w0); pa[2 + s] = __builtin_bit_cast(bf16x8, w1);
    }
    const int i16 = lane & 15, q4 = i16 >> 2, pp = i16 & 3, blk = (lane >> 4) & 1;
    const LAS unsigned char* vb = lds + L_V + (4 * h + q4) * VSTR + hcolb + 32 * blk + 8 * pp;
#pragma unroll
    for (int s = 0; s < 4; ++s) {
        if (!((SUBS >> (s >> 1)) & 1)) continue;
        const s16x4 lo0 = vtr(vb + (16 * s) * VSTR), hi0 = vtr(vb + (16 * s + 8) * VSTR);
        const s16x4 lo1 = vtr(vb + (16 * s) * VSTR + 64), hi1 = vtr(vb + (16 * s + 8) * VSTR + 64);
        const bf16x8 v0 = __builtin_shufflevector(lo0, hi0, 0, 1, 2, 3, 4, 5, 6, 7), v1 = __builtin_shufflevector(lo1, hi1, 0, 1, 2, 3, 4, 5, 6, 7);
        o0 = MFMA32(pa[s], v0, o0); o1 = MFMA32(pa[s], v1, o1);
    }
}

template <int HALF> DI void tile_compute_b(LAS unsigned char* lds, const bf16x8 (&qf)[4], float& l, f32x16& o0, f32x16& o1,
                                           int hcolb, int lane, const LAS float* tab_lane, int e0) {
    const int r = lane & 31, h = lane >> 5;
    f32x16 p0, p1;
#pragma unroll
    for (int i = 0; i < 16; ++i) { const int c = (i & 3) + 8 * (i >> 2);
        p0[i] = (HALF == 0 || i >= 12) ? tab_lane[c] : 0.f; p1[i] = (HALF == 1 || i < 4) ? tab_lane[c + 32] : 0.f; }
    const LAS unsigned char* kb = lds + L_K + r * KSTR + hcolb + 16 * h;
#pragma unroll
    for (int ds = 0; ds < 4; ++ds) {
        const bf16x8 k0 = *(const LAS bf16x8*)(kb + ds * 32);
        const bf16x8 k1 = *(const LAS bf16x8*)(kb + 32 * KSTR + ds * 32);
        p0 = MFMA32(k0, qf[ds], p0); p1 = MFMA32(k1, qf[ds], p1);
    }
    float sum = 0.f;
#pragma unroll
    for (int i = 0; i < 16; ++i) { const int c = (i & 3) + 8 * (i >> 2);
        if (HALF == 0 || i >= 12) { p0[i] = __builtin_amdgcn_exp2f(((unsigned)(e0 + c) < 16u) ? p0[i] : -INFINITY); sum += p0[i]; } else p0[i] = 0.f;
        if (HALF == 1 || i < 4) { p1[i] = __builtin_amdgcn_exp2f(((unsigned)(e0 + c + 32) < 16u) ? p1[i] : -INFINITY); sum += p1[i]; } else p1[i] = 0.f; }
    l += sum;
    bf16x8 pa[4];
#pragma unroll
    for (int s = 0; s < 2; ++s) {
        u32x4 w0, w1;
        w0.x = pk_bf16(p0[8 * s + 0], p0[8 * s + 1]); w0.y = pk_bf16(p0[8 * s + 2], p0[8 * s + 3]); w0.z = pk_bf16(p0[8 * s + 4], p0[8 * s + 5]); w0.w = pk_bf16(p0[8 * s + 6], p0[8 * s + 7]);
        w1.x = pk_bf16(p1[8 * s + 0], p1[8 * s + 1]); w1.y = pk_bf16(p1[8 * s + 2], p1[8 * s + 3]); w1.z = pk_bf16(p1[8 * s + 4], p1[8 * s + 5]); w1.w = pk_bf16(p1[8 * s + 6], p1[8 * s + 7]);
        pa[s] = __builtin_bit_cast(bf16x8, w0); pa[2 + s] = __builtin_bit_cast(bf16x8, w1);
    }
    const int i16 = lane & 15, q4 = i16 >> 2, pp = i16 & 3, blk = (lane >> 4) & 1;
    const LAS unsigned char* vb = lds + L_V + (4 * h + q4) * VSTR + hcolb + 32 * blk + 8 * pp;
#pragma unroll
    for (int s = 0; s < 4; ++s) {
        if ((HALF == 0 && s == 3) || (HALF == 1 && s == 0)) continue;
        const s16x4 lo0 = vtr(vb + (16 * s) * VSTR), hi0 = vtr(vb + (16 * s + 8) * VSTR);
        const s16x4 lo1 = vtr(vb + (16 * s) * VSTR + 64), hi1 = vtr(vb + (16 * s + 8) * VSTR + 64);
        const bf16x8 v0 = __builtin_shufflevector(lo0, hi0, 0, 1, 2, 3, 4, 5, 6, 7), v1 = __builtin_shufflevector(lo1, hi1, 0, 1, 2, 3, 4, 5, 6, 7);
        o0 = MFMA32(pa[s], v0, o0); o1 = MFMA32(pa[s], v1, o1);
    }
}

DI void write_ost(LAS unsigned char* lds, LAS float* wsf, float l, const f32x16& o0, const f32x16& o1, int rt, int ocol, int lane) {
    const int r = lane & 31, h = lane >> 5;
    const float lt = l + __shfl_xor(l, 32);
    if (h == 0) wsf[r] = 1.0f / lt;
    asm volatile("s_waitcnt lgkmcnt(0)" ::: "memory");
#pragma unroll
    for (int g = 0; g < 4; ++g) { const f32x4 a = *(const LAS f32x4*)(wsf + 8 * g + 4 * h);
#pragma unroll
        for (int j = 0; j < 4; ++j) { const int i = 4 * g + j, row = 32 * rt + j + 8 * g + 4 * h;
            LAS bf16_t* op = (LAS bf16_t*)(lds + L_O + row * OSTR) + ocol + r;
            op[0] = (bf16_t)(pk_bf16(o0[i] * a[j], 0.f) & 0xffffu); op[32] = (bf16_t)(pk_bf16(o1[i] * a[j], 0.f) & 0xffffu); } }
    asm volatile("s_waitcnt lgkmcnt(0)" ::: "memory");
}
template <int NC> DI void finalize(LAS unsigned char* lds, bf16_t* o, int row0, int gcol, int tid) {
    __syncthreads();
    const int token = tid >> 3, c8 = tid & 7;
    u32x4 v[NC / 64]; float ss = 0.f;
#pragma unroll
    for (int j = 0; j < NC / 64; ++j) { v[j] = *(const LAS u32x4*)(lds + L_O + token * OSTR + (64 * j + 8 * c8) * 2);
#pragma unroll
        for (int e = 0; e < 4; ++e) { const float a = bf_lo(v[j][e]), b = bf_hi(v[j][e]); ss += a * a + b * b; } }
    ss += __shfl_xor(ss, 1); ss += __shfl_xor(ss, 2); ss += __shfl_xor(ss, 4);
    const float rstd = rsqrtf(ss * (1.0f / NC) + EPS);
#pragma unroll
    for (int j = 0; j < NC / 64; ++j) { u32x4 w;
#pragma unroll
        for (int e = 0; e < 4; ++e) w[e] = pk_bf16(bf_lo(v[j][e]) * rstd, bf_hi(v[j][e]) * rstd);
        __builtin_nontemporal_store(w, (u32x4*)(o + (size_t)(row0 + token) * DM + gcol + 64 * j + 8 * c8)); }
}

DI void load_q(bf16x8 (&qf)[4], const bf16_t* p) {
#pragma unroll
    for (int ds = 0; ds < 4; ++ds) qf[ds] = *(const bf16x8*)(p + 16 * ds);
}

DI void attn_unit(LAS unsigned char* lds, const Args& a, int u) {
    int tid_ = threadIdx.x; asm volatile("" : "+v"(tid_));
    const int tid = tid_, lane = tid & 63, wid = __builtin_amdgcn_readfirstlane(tid >> 6), r = lane & 31, h = lane >> 5;
    const int hg = wid >> 1, rt = wid & 1;
    const int row0 = u * 64;
    int S, seq_start, memrow0;
    if (row0 < NPROMPT) { S = 8192; const int b = row0 >> 13; seq_start = b << 13; memrow0 = b * 256; }
    else { S = 4096; const int b = (row0 - NPROMPT) >> 12; seq_start = NPROMPT + (b << 12); memrow0 = 2048 + b * 256; }
    const int pos0 = row0 - seq_start;
    const int R = S >> 6, rq = pos0 >> 6; int rstart = rq - 4; rstart = rstart < 0 ? 0 : rstart; rstart = rstart > R - 8 ? R - 8 : rstart;
    const bf16_t* projS = a.proj + (size_t)seq_start * PITCH;
    const bf16_t* qrow = a.proj + (size_t)(row0 + 32 * rt + r) * PITCH + 8 * h;
    LAS float* wsf = (LAS float*)(lds + L_WS) + wid * 64;
    const LAS float* rpbL = (const LAS float*)(lds + L_RPB);
    const bf16_t* memK = a.memkv + (size_t)memrow0 * DM + a.layer * 512;
    u32x4 kr[4], vr[4];
    bf16x8 qf[4]; float l; f32x16 o0, o1;
    const LAS float* cst = (const LAS float*)(lds + L_CST); const LAS float* alibiL = (const LAS float*)(lds + L_ALIBI);
#define GLOAD_A(kvh, t) do { const int tp_ = pos0 - 128 + 64 * (t); if (tp_ >= 0 && tp_ < S) tile_gload<64>(kr, vr, projS + (size_t)tp_ * PITCH + 512 + 64 * (kvh), projS + (size_t)tp_ * PITCH + 640 + 64 * (kvh), PITCH, tid); } while (0)
#define GLOAD_B(t) tile_gload<256>(kr, vr, projS + (size_t)(64 * (rstart + (t))) * PITCH + 1024, projS + (size_t)(64 * (rstart + (t))) * PITCH + 1280, PITCH, tid)
#define GLOAD_M(t) tile_gload<256>(kr, vr, memK + (size_t)(64 * (t)) * DM, memK + (size_t)(64 * (t)) * DM + 256, DM, tid)
#define ZERO_O() do { _Pragma("unroll") for (int i_ = 0; i_ < 16; ++i_) { o0[i_] = 0.f; o1[i_] = 0.f; } } while (0)
#define A_TP(t) (pos0 - 128 + 64 * (t))
#define A_OK(t) ((t) < 5 && A_TP(t) >= 0 && A_TP(t) < S)
#define A_GL(kvh, t, i) do { if (A_OK(t)) { const bf16_t* kp_ = projS + (size_t)A_TP(t) * PITCH + 512 + 64 * (kvh) + ((unsigned)tid >> 3) * (unsigned)PITCH + ((unsigned)tid & 7u) * 8u; \
        kr[i] = *(const u32x4*)kp_; vr[i] = *(const u32x4*)(kp_ + 128); } } while (0)
#define A_ST(i, cofs) do { LAS unsigned char* kd_ = lds + L_K + ((unsigned)tid >> 3) * KSTR + (cofs) + ((unsigned)tid & 7u) * 16; LAS unsigned char* vd_ = lds + L_V + ((unsigned)tid >> 3) * VSTR + (cofs) + ((unsigned)tid & 7u) * 16; \
        *(LAS u32x4*)kd_ = kr[i]; *(LAS u32x4*)vd_ = vr[i]; } while (0)
    A_GL(0, 0, 0); A_GL(0, 1, 1);
#pragma unroll 1
    for (int kvh = 0; kvh < 2; ++kvh) {
        const int head = 4 * kvh + hg;
        load_q(qf, qrow + 64 * head);
        { const float sink2 = a.sink[a.layer * 8 + head] * LOG2E; l = (h == 0) ? __builtin_amdgcn_exp2f(sink2 - fmaxf(cst[0], sink2)) : 0.0f; } ZERO_O();
        const LAS float* tl0 = alibiL + head * NAL + (4 * h - (pos0 + 32 * rt + r) + 192);
#pragma unroll 1
        for (int sp = 0; sp < 3; ++sp) {
            const int ta = 2 * sp, tb = 2 * sp + 1; const bool va = A_OK(ta), vb = A_OK(tb);
            if (va) A_ST(0, 0);
            if (vb) A_ST(1, 128);
            __syncthreads();
            if (sp < 2) { A_GL(kvh, ta + 2, 0); A_GL(kvh, tb + 2, 1); } else if (kvh == 0) { A_GL(1, 0, 0); A_GL(1, 1, 1); } else GLOAD_B(0);
            if (va) { const LAS float* tl = tl0 + A_TP(ta);
                if (ta == 4 && rt == 0) tile_compute<0, 1>(lds, qf, l, o0, o1, 0, lane, tl, 0, 0.f);
                else if (ta == 0 && rt == 1) tile_compute<0, 2>(lds, qf, l, o0, o1, 0, lane, tl, 0, 0.f);
                else tile_compute<0, 3>(lds, qf, l, o0, o1, 0, lane, tl, 0, 0.f); }
            if (vb) tile_compute<0, 3>(lds, qf, l, o0, o1, 128, lane, tl0 + A_TP(tb), 0, 0.f);
            __syncthreads();
        }
        write_ost(lds, wsf, l, o0, o1, rt, 64 * head, lane);
    }
#undef A_TP
#undef A_OK
#undef A_GL
#undef A_ST
    finalize<512>(lds, a.o, row0, 0, tid);
    {
        load_q(qf, qrow + 768 + 64 * hg);
        l = 0.f; ZERO_O();
        const int cq = 32 * rt + r; int cs = cq - 8; cs = cs < 0 ? 0 : cs; cs = cs > 48 ? 48 : cs;
        const int e0 = 4 * h - cs;
#pragma unroll 1
        for (int t = 0; t < 8; ++t) {
            tile_lstore<256>(lds, kr, vr, tid);
            __syncthreads();
            if (t < 7) GLOAD_B(t + 1); else GLOAD_M(0);
            const LAS float* rl = rpbL + hg * 465 + (rstart + t - rq + 7) * 31 + (4 * h - cq + 15);
            if (rt == 0) tile_compute_b<0>(lds, qf, l, o0, o1, 128 * hg, lane, rl, e0); else tile_compute_b<1>(lds, qf, l, o0, o1, 128 * hg, lane, rl, e0);
            __syncthreads();
        }
        write_ost(lds, wsf, l, o0, o1, rt, 64 * hg, lane);
    }
    finalize<256>(lds, a.o, row0, 512, tid);
    {
        load_q(qf, qrow + 1536 + 64 * hg);
        l = 0.f; ZERO_O();
        const float negcm = -cst[2];
#pragma unroll 1
        for (int t = 0; t < 4; ++t) {
            tile_lstore<256>(lds, kr, vr, tid);
            __syncthreads();
            if (t < 3) GLOAD_M(t + 1);
            tile_compute<2>(lds, qf, l, o0, o1, 128 * hg, lane, rpbL, 0, negcm);
            __syncthreads();
        }
        write_ost(lds, wsf, l, o0, o1, rt, 64 * hg, lane);
    }
    finalize<256>(lds, a.o, row0, 768, tid);
    __syncthreads();
#undef GLOAD_A
#undef GLOAD_B
#undef GLOAD_M
#undef ZERO_O
}

DI void attn_phase(LAS unsigned char* lds, const Args& a, int G, int bid) {
    int tid_ = threadIdx.x; asm volatile("" : "+v"(tid_)); const int tid = tid_;
    LAS float* rpbL = (LAS float*)(lds + L_RPB); LAS float* cst = (LAS float*)(lds + L_CST); LAS float* alibiL = (LAS float*)(lds + L_ALIBI);
    {
        const int wv = tid >> 6, ln = tid & 63;
        if (wv < 6) { float g = __builtin_fabsf(a.gains[wv * 64 + ln]);
#pragma unroll
            for (int o = 1; o < 64; o <<= 1) g = fmaxf(g, __shfl_xor(g, o));
            if (ln == 0) cst[8 + wv] = g; }
        __syncthreads();
        if (tid < 3) cst[tid] = 8.0f * LOG2E * cst[8 + 2 * tid] * cst[9 + 2 * tid];
        __syncthreads();
    }
    { const float cA = cst[0], cB = cst[1];
      for (int i = tid; i < 1860; i += 512) rpbL[i] = a.rpb[a.layer * 1860 + i] * LOG2E - cB;
      for (int i = tid; i < 8 * NAL; i += 512) { const int hh = i / NAL, d = i % NAL - 192, ad = d < 0 ? -d : d;
          const float sink2 = a.sink[a.layer * 8 + hh] * LOG2E, c2 = fmaxf(cA, sink2), slope2 = __builtin_amdgcn_exp2f(-(float)(hh + 1)) * LOG2E;
          alibiL[i] = (ad <= 128) ? -slope2 * (float)ad - c2 : -INFINITY; } }
    __syncthreads();
    const int nunits = NTOK / 64, upc = (nunits + G - 1) / G;
    const int vcu = (G % 8 == 0) ? (bid % 8) * (G / 8) + bid / 8 : bid;
    for (int i = 0; i < upc; ++i) { const int u = vcu * upc + i; if (u < nunits) attn_unit(lds, a, u); }
}
}

constexpr size_t MiB = 1u << 20;
constexpr size_t WS_WIN = 0, WS_WOUT = 7 * MiB, WS_WFF1 = 11 * MiB, WS_WFF2 = 27 * MiB, WS_WMEM = 43 * MiB, WS_MEMB = 45 * MiB, WS_MEMKV = 51 * MiB,
                 WS_STATS = 57 * MiB, WS_MSTATS = 62 * MiB, WS_CTL = 63 * MiB, WS_XB = 64 * MiB, WS_PROJ = 224 * MiB, WS_O = 504 * MiB, WS_HID = 224 * MiB, WS_STATS2 = 864 * MiB, WS_END = 869 * MiB;
constexpr int LDS_BYTES = 160 * 1024, LDS_BARW = LDS_BYTES - 64, CTL_BYTES = 16384;
static_assert(att::L_END <= LDS_BYTES && pg8::EPI_P + 8192 <= LDS_BYTES, "LDS map");

struct Params {
    const float *x_prompt, *x_sample, *mem_prompt, *mem_sample, *g_mix, *w_in, *qk_gain, *sink, *rpb, *o_gain, *w_out, *g_mem, *w_mem_kv, *g_ff, *w_ff1, *w_ff2;
    float* out; unsigned char* ws;
};

DI float wave_sum(float v) {
#pragma unroll
    for (int o = 1; o < 64; o <<= 1) v += __shfl_xor(v, o);
    return v;
}
DI void transpose_item(const float* W, const float* g, int K, int N, bf16_t* WT, LAS float* scr, int item, int lane) {
    const int nblk = N / 32, kb = item / nblk, nb = item % nblk, k0 = 64 * kb, n0 = 32 * nb;
    float wv[32];
#pragma unroll
    for (int i = 0; i < 32; ++i) { const int kk = 2 * i + (lane >> 5); wv[i] = W[(size_t)(k0 + kk) * N + n0 + (lane & 31)]; }
    const float gl = g ? g[k0 + lane] : 1.0f;
#pragma unroll
    for (int i = 0; i < 32; ++i) { const int kk = 2 * i + (lane >> 5); scr[kk * 33 + (lane & 31)] = wv[i] * __shfl(gl, kk); }
    asm volatile("s_waitcnt lgkmcnt(0)" ::: "memory");
    const int c = lane & 7;
#pragma unroll
    for (int j = 0; j < 4; ++j) { const int n = (lane >> 3) + 8 * j; const LAS float* s = scr + (8 * c) * 33 + n;
        u32x4 o; o.x = pk_bf16(s[0 * 33], s[1 * 33]); o.y = pk_bf16(s[2 * 33], s[3 * 33]); o.z = pk_bf16(s[4 * 33], s[5 * 33]); o.w = pk_bf16(s[6 * 33], s[7 * 33]);
        *(u32x4*)(WT + (size_t)(n0 + n) * K + k0 + 8 * c) = o; }
    asm volatile("s_waitcnt lgkmcnt(0)" ::: "memory");
}
DI void rows4_to_bf16(const float* xrow, bf16_t* orow, float* st, int lane) {
    f32x4 v[4][4]; float s[4];
#pragma unroll
    for (int r = 0; r < 4; ++r)
#pragma unroll
        for (int j = 0; j < 4; ++j) v[r][j] = *((const f32x4*)(xrow + (size_t)r * DM) + lane + 64 * j);
#pragma unroll
    for (int r = 0; r < 4; ++r) { s[r] = (dot4(v[r][0]) + dot4(v[r][1])) + (dot4(v[r][2]) + dot4(v[r][3])); }
#pragma unroll
    for (int o = 1; o < 64; o <<= 1) {
#pragma unroll
        for (int r = 0; r < 4; ++r) s[r] += __shfl_xor(s[r], o);
    }
#pragma unroll
    for (int r = 0; r < 4; ++r) {
        u32x2* o8 = (u32x2*)(orow + (size_t)r * DM) + lane;
#pragma unroll
        for (int j = 0; j < 4; ++j) { u32x2 w; w.x = pk_bf16(v[r][j][0], v[r][j][1]); w.y = pk_bf16(v[r][j][2], v[r][j][3]); o8[64 * j] = w; }
    }
    const float mine = (lane == 0) ? s[0] : (lane == 16) ? s[1] : (lane == 32) ? s[2] : (lane == 48) ? s[3] : 0.f;
    st[lane] = mine;
}
#define XB_TMO      128
#define XB_XCNT(j)  (256  + 64 * (j))
#define XB_XSUB(j)  (1280 + 64 * (j))
#define XB_XGEN(j)  (2304 + 64 * (j))
#define XB_TOP      3328
#define XB_TOPGEN   3392
#define XCD_BAR_WORDS 3456
#define XB_SPIN_CAP (1u << 18)
DI unsigned xb_ld(unsigned* p)              { return __hip_atomic_load(p, __ATOMIC_RELAXED, __HIP_MEMORY_SCOPE_AGENT); }
DI unsigned xb_add(unsigned* p, unsigned v) { return __hip_atomic_fetch_add(p, v, __ATOMIC_RELAXED, __HIP_MEMORY_SCOPE_AGENT); }
DI unsigned xb_xcc_id() { return (unsigned)__builtin_amdgcn_s_getreg((3 << 11) | 20) & 0xFu; }
#define XB_SPIN(cond, bar) do { unsigned _sp = 0; while (cond) { __builtin_amdgcn_s_sleep(1); \
    if ((++_sp & 255u) == 0u) { if (xb_ld(&(bar)[XB_TMO])) break; if (_sp > XB_SPIN_CAP) { atomicAdd(&(bar)[XB_TMO], 1u); break; } } } } while (0)
struct XcdBarrier { unsigned* bar; unsigned x; volatile LAS unsigned* st; };
DI XcdBarrier xcd_barrier_post(unsigned* bar, volatile LAS unsigned* st) {
    XcdBarrier b; b.bar = bar; b.x = xb_xcc_id(); b.st = st;
    if (threadIdx.x == 0) (void)xb_add(&bar[XB_XCNT(b.x)], 1u);
    return b;
}
DI void xcd_barrier_complete(unsigned* bar, unsigned x, unsigned& nloc, unsigned& nx) {
    const unsigned G = gridDim.x * gridDim.y * gridDim.z;
    unsigned sum, cnt, mine, sp = 0u;
    for (;;) {
        sum = 0u; cnt = 0u; mine = 0u;
#pragma unroll
        for (unsigned j = 0; j < 16; ++j) { const unsigned c = xb_ld(&bar[XB_XCNT(j)]); sum += c; cnt += (c > 0u) ? 1u : 0u; mine = (j == x) ? c : mine; }
        if (sum == G) break;
        __builtin_amdgcn_s_sleep(1);
        if ((++sp & 255u) == 0u) { if (xb_ld(&bar[XB_TMO])) break; if (sp > XB_SPIN_CAP) { atomicAdd(&bar[XB_TMO], 1u); break; } }
    }
    nloc = mine > 0u ? mine : 1u; nx = cnt > 0u ? cnt : 1u;
}
DI void xcd_barrier(const XcdBarrier& b) {
    asm volatile("s_waitcnt vmcnt(0)" ::: "memory");
    __syncthreads();
    if (threadIdx.x == 0) {
        unsigned* bar = b.bar;
        __builtin_amdgcn_s_waitcnt(0);
        unsigned nloc = b.st[0], nx = b.st[1];
        if (nloc == 0u) { xcd_barrier_complete(bar, b.x, nloc, nx); b.st[0] = nloc; b.st[1] = nx; }
        const unsigned old = xb_add(&bar[XB_XSUB(b.x)], 1u);
        const unsigned gen = old / nloc;
        if (old + 1u == (gen + 1u) * nloc) {
            __builtin_amdgcn_fence(__ATOMIC_RELEASE, "agent");
            asm volatile("s_waitcnt vmcnt(0)" ::: "memory");
            const unsigned og = xb_add(&bar[XB_TOP], 1u);
            const unsigned tg = og / nx;
            if (og + 1u == (tg + 1u) * nx) xb_add(&bar[XB_TOPGEN], 1u);
            else XB_SPIN(xb_ld(&bar[XB_TOPGEN]) == tg, bar);
            __builtin_amdgcn_fence(__ATOMIC_ACQUIRE, "agent");
            xb_add(&bar[XB_XGEN(b.x)], 1u);
            asm volatile("s_waitcnt vmcnt(0)" ::: "memory");
        } else {
            XB_SPIN(xb_ld(&bar[XB_XGEN(b.x)]) == gen, bar);
            __builtin_amdgcn_fence(__ATOMIC_ACQUIRE, "agent");
            asm volatile("s_waitcnt vmcnt(0)" ::: "memory");
        }
    }
    __syncthreads();
}

__global__ void __launch_bounds__(512, 2) fwd_megakernel(Params p) {
    extern __shared__ __attribute__((aligned(16))) unsigned char lds_raw[];
    LAS unsigned char* lds = (LAS unsigned char*)lds_raw;
    cg::grid_group grid = cg::this_grid();
    const int tid = threadIdx.x, lane = tid & 63, wave = __builtin_amdgcn_readfirstlane(tid >> 6);
    const int G = gridDim.x, bid = blockIdx.x;
    volatile LAS unsigned* barw = (volatile LAS unsigned*)(lds + LDS_BARW);
    if (tid < 2) barw[tid] = 0u;
    __syncthreads();
    XcdBarrier xbar = xcd_barrier_post((unsigned*)(p.ws + WS_CTL), barw);
    typedef const __attribute__((address_space(4))) Params* KP;
    KP kp0 = (KP)__builtin_amdgcn_kernarg_segment_ptr();
#define PHASE_PTRS() KP kp = kp0; asm volatile("" : "+s"(kp)); unsigned char* ws = kp->ws; \
    bf16_t* WIN = (bf16_t*)(ws + WS_WIN); bf16_t* WOUT = (bf16_t*)(ws + WS_WOUT); bf16_t* WFF1 = (bf16_t*)(ws + WS_WFF1); bf16_t* WFF2 = (bf16_t*)(ws + WS_WFF2); bf16_t* WMEM = (bf16_t*)(ws + WS_WMEM); \
    bf16_t* MEMB = (bf16_t*)(ws + WS_MEMB); bf16_t* MEMKV = (bf16_t*)(ws + WS_MEMKV); float* STATS = (float*)(ws + WS_STATS); float* STATS2 = (float*)(ws + WS_STATS2); float* MSTATS = (float*)(ws + WS_MSTATS); \
    bf16_t* XB = (bf16_t*)(ws + WS_XB); bf16_t* PROJ = (bf16_t*)(ws + WS_PROJ); bf16_t* OB = (bf16_t*)(ws + WS_O); bf16_t* HID = (bf16_t*)(ws + WS_HID); \
    (void)WIN; (void)WOUT; (void)WFF1; (void)WFF2; (void)WMEM; (void)MEMB; (void)MEMKV; (void)STATS; (void)STATS2; (void)MSTATS; (void)XB; (void)PROJ; (void)OB; (void)HID;

    {
        PHASE_PTRS();
        LAS float* scr = (LAS float*)(lds + wave * 16384);
        const int gw = bid * 8 + wave, NGW = G * 8;
        constexpr int I_IN = 16 * 56, I_OUT = 16 * 32, I_FF1 = 16 * 128, I_FF2 = 64 * 32, I_MEM = 16 * 16, I_L = I_IN + I_OUT + I_FF1 + I_FF2 + I_MEM;
        for (int it = gw; it < 2 * I_L; it += NGW) {
            const int l = it / I_L; int r = it % I_L;
            if (r < I_IN) { transpose_item(kp->w_in + (size_t)l * DM * INW, kp->g_mix + l * DM, DM, INW, WIN + (size_t)l * INW * DM, scr, r, lane); continue; } r -= I_IN;
            if (r < I_OUT) { transpose_item(kp->w_out + (size_t)l * DM * DM, kp->o_gain + l * DM, DM, DM, WOUT + (size_t)l * DM * DM, scr, r, lane); continue; } r -= I_OUT;
            if (r < I_FF1) { transpose_item(kp->w_ff1 + (size_t)l * DM * DFF, kp->g_ff + l * DM, DM, DFF, WFF1 + (size_t)l * DFF * DM, scr, r, lane); continue; } r -= I_FF1;
            if (r < I_FF2) { transpose_item(kp->w_ff2 + (size_t)l * DFF * DM, nullptr, DFF, DM, WFF2 + (size_t)l * DM * DFF, scr, r, lane); continue; } r -= I_FF2;
            transpose_item(kp->w_mem_kv + (size_t)l * DM * 512, kp->g_mem + l * DM, DM, 512, WMEM + (size_t)l * 512 * DM, scr, r, lane);
        }
        for (int m4 = gw; m4 < (NTOK + NMEMROWS) / 4; m4 += NGW) {
            const int m = m4 * 4;
            if (m < NTOK) { const float* src = (m < NPROMPT) ? kp->x_prompt + (size_t)m * DM : kp->x_sample + (size_t)(m - NPROMPT) * DM; rows4_to_bf16(src, XB + (size_t)m * DM, STATS + (size_t)m * 16, lane); }
            else { const int mm = m - NTOK; const float* src = (mm < 2048) ? kp->mem_prompt + (size_t)mm * DM : kp->mem_sample + (size_t)(mm - 2048) * DM; rows4_to_bf16(src, MEMB + (size_t)mm * DM, MSTATS + (size_t)mm * 16, lane); }
        }
    }
    grid.sync();

#pragma unroll 1
    for (int l = 0; l < 2; ++l) {
        {
            PHASE_PTRS();
            pg8::Gemm g{XB, WIN + (size_t)l * INW * DM, NTOK, INW, DM}; pg8::StaticOrder S; S.init(NTOK, INW, G, bid);
            pg8::EpiProj E{PROJ, INW, STATS, kp->qk_gain + l * 384, 0, lds};
            pg8::gemm_phase<pg8::EpiProj, pg8::StaticOrder, true, true>(lds, g, S, E);
            if (l == 0) {
                pg8::Gemm gm{MEMB, WMEM, NMEMROWS, 1024, DM}; pg8::StaticOrder Sm; Sm.init(NMEMROWS, 1024, G, (bid + 64) % G);
                pg8::EpiProj Em{MEMKV, 1024, MSTATS, kp->qk_gain, 1, lds};
                pg8::gemm_phase<pg8::EpiProj, pg8::StaticOrder, true, true>(lds, gm, Sm, Em);
            }
        }
        xcd_barrier(xbar);
        {
            PHASE_PTRS();
            att::Args a{PROJ, MEMKV, OB, kp->sink, kp->rpb, kp->qk_gain + l * 384, l};
            att::attn_phase(lds, a, G, bid);
        }
        xcd_barrier(xbar);
        {
            PHASE_PTRS();
            pg8::Gemm g{OB, WOUT + (size_t)l * DM * DM, NTOK, DM, DM}; pg8::StaticOrder S; S.init(NTOK, DM, G, bid);
            pg8::EpiRes E{XB, nullptr, nullptr, STATS2, lds};
            pg8::gemm_phase<pg8::EpiRes, pg8::StaticOrder, true, true>(lds, g, S, E);
        }
        xcd_barrier(xbar);
        {
            PHASE_PTRS();
            pg8::Gemm g{XB, WFF1 + (size_t)l * DFF * DM, NTOK, DFF, DM}; pg8::StaticOrder S; S.init(NTOK, DFF, G, bid);
            pg8::EpiFF1 E{HID};
            pg8::gemm_phase<pg8::EpiFF1, pg8::StaticOrder, true, true>(lds, g, S, E);
        }
        xcd_barrier(xbar);
        {
            PHASE_PTRS();
            pg8::Gemm g{HID, WFF2 + (size_t)l * DM * DFF, NTOK, DM, DFF}; pg8::StaticOrder S; S.init(NTOK, DM, G, bid);
            pg8::EpiRes E{XB, l == 1 ? kp->out : nullptr, STATS2, l == 1 ? nullptr : STATS, lds};
            pg8::gemm_phase<pg8::EpiRes, pg8::StaticOrder, true, true>(lds, g, S, E);
        }
        if (l == 0) xcd_barrier(xbar);
    }
}

extern "C" void kernel_launch(void* const* d_in, const int* in_sizes, int n_in, void* d_out, int out_size, void* d_ws, size_t ws_size, hipStream_t stream) {
    static int grid_blocks = 0;
    if (grid_blocks == 0) {
        if (n_in != 16 || out_size != NTOK * DM || ws_size < WS_END) { fprintf(stderr, "kernel_launch: unexpected shapes: n_in %d out %d ws %zu\n", n_in, out_size, ws_size); grid_blocks = -1; return; }
        int dev = 0, cus = 0, per_cu = 0;
        hipGetDevice(&dev);
        hipDeviceGetAttribute(&cus, hipDeviceAttributeMultiprocessorCount, dev);
        if (hipFuncSetAttribute((const void*)fwd_megakernel, hipFuncAttributeMaxDynamicSharedMemorySize, LDS_BYTES) != hipSuccess) { fprintf(stderr, "kernel_launch: hipFuncSetAttribute failed\n"); grid_blocks = -1; return; }
        if (hipOccupancyMaxActiveBlocksPerMultiprocessor(&per_cu, (const void*)fwd_megakernel, 512, LDS_BYTES) != hipSuccess || per_cu < 1) { fprintf(stderr, "kernel_launch: occupancy query gave %d\n", per_cu); per_cu = 1; }
        (void)hipGetLastError();
        grid_blocks = cus * 1;
    }
    if (grid_blocks < 0) return;
    Params p{};
    p.x_prompt = (const float*)d_in[0]; p.x_sample = (const float*)d_in[1]; p.mem_prompt = (const float*)d_in[2]; p.mem_sample = (const float*)d_in[3];
    p.g_mix = (const float*)d_in[4]; p.w_in = (const float*)d_in[5]; p.qk_gain = (const float*)d_in[6]; p.sink = (const float*)d_in[7]; p.rpb = (const float*)d_in[8];
    p.o_gain = (const float*)d_in[9]; p.w_out = (const float*)d_in[10]; p.g_mem = (const float*)d_in[11]; p.w_mem_kv = (const float*)d_in[12]; p.g_ff = (const float*)d_in[13];
    p.w_ff1 = (const float*)d_in[14]; p.w_ff2 = (const float*)d_in[15];
    p.out = (float*)d_out; p.ws = (unsigned char*)d_ws;
    if (hipMemsetAsync((char*)d_ws + WS_CTL, 0, CTL_BYTES, stream) != hipSuccess) { fprintf(stderr, "kernel_launch: hipMemsetAsync failed\n"); return; }
    void* args[] = {&p};
    hipError_t e = hipLaunchCooperativeKernel((const void*)fwd_megakernel, dim3(grid_blocks), dim3(512), args, LDS_BYTES, stream);
    if (e != hipSuccess) fprintf(stderr, "kernel_launch: cooperative launch failed: %s (grid %d)\n", hipGetErrorString(e), grid_blocks);
}
```

```cpp
#include <hip/hip_runtime.h>
#include <hip/hip_cooperative_groups.h>
#include <cstdio>
#include <cstdint>
namespace cg = cooperative_groups;

#define LAS __attribute__((address_space(3)))
#define DI __device__ __forceinline__
typedef unsigned short bf16_t;
typedef short bf16x8 __attribute__((ext_vector_type(8)));
typedef float f32x4 __attribute__((ext_vector_type(4)));
typedef float f32x16 __attribute__((ext_vector_type(16)));
typedef unsigned u32x4 __attribute__((ext_vector_type(4)));
typedef unsigned u32x2 __attribute__((ext_vector_type(2)));
typedef short s16x4 __attribute__((ext_vector_type(4)));

constexpr int DM = 1024, NTOK = 81920, NPROMPT = 65536, INW = 1792, DFF = 4096, NMEMROWS = 3072;
constexpr float EPS = 1e-6f, LOG2E = 1.4426950408889634f, QSCALE = 0.125f * 1.4426950408889634f;

DI unsigned pk_bf16(float lo, float hi) {
    typedef float f2 __attribute__((ext_vector_type(2))); typedef __bf16 b2 __attribute__((ext_vector_type(2)));
    f2 v = {lo, hi}; b2 o = __builtin_convertvector(v, b2); return __builtin_bit_cast(unsigned, o);
}
DI float dot4(f32x4 a) { return (a[0] * a[0] + a[1] * a[1]) + (a[2] * a[2] + a[3] * a[3]); }
DI float bf_lo(unsigned u) { return __uint_as_float(u << 16); }
DI float bf_hi(unsigned u) { return __uint_as_float(u & 0xffff0000u); }

namespace pg8 {
constexpr int BM = 256, BK = 64, HALF = 128, HTB = HALF * BK * 2, STAGE_BYTES = 8 * HTB, NXCD = 8, WGM = 8;
constexpr int EPI_RS = STAGE_BYTES, EPI_P = STAGE_BYTES + 1024;

__host__ __device__ __forceinline__ int lds_byte(int r, int c) { const int st = (r >> 4) * 2 + (c >> 5), rr = r & 15, cc = c & 31, ob = rr * 64 + cc * 2; return st * 1024 + (ob ^ (((ob >> 9) & 1) << 5)); }
__host__ __device__ __forceinline__ void stage_rc(int b, int& R, int& C) { const int st = b / 1024, sb = b % 1024, swz = sb ^ (((sb >> 9) & 1) << 5); R = (st >> 1) * 16 + swz / 64; C = (st & 1) * 32 + (swz % 64) / 2; }
__host__ __device__ __forceinline__ int perm32(int rho) { const int n = rho >> 4, i = rho & 15; return 8 * (i >> 2) + 4 * n + (i & 3); }

struct Unit { int pm, pn; };
struct Gemm { const bf16_t* A; const bf16_t* Bt; int M, N, K; };

struct StaticOrder {
    int nM, nN, nwg, G, c;
    __host__ __device__ void init(int M, int N, int G_, int c_) { nM = M / BM; nN = N / BM; nwg = nM * nN; G = G_; c = c_; }
    __host__ __device__ bool next(int i, Unit& u) const {
        const long L = (long)i * G + c; if (L >= nwg) return false;
        int wgid = (int)L; { const int q = nwg / NXCD, r = nwg % NXCD, xcd = wgid % NXCD, off = wgid / NXCD; wgid = (xcd < r ? xcd * (q + 1) : r * (q + 1) + (xcd - r) * q) + off; }
        const int nig = WGM * nN, gid = wgid / nig, fm = gid * WGM, gsz = (nM - fm) < WGM ? (nM - fm) : WGM;
        u.pm = fm + ((wgid % nig) % gsz); u.pn = (wgid % nig) / gsz; return true;
    }
    __device__ __forceinline__ void a_ready(const Unit&) const {}
    __device__ __forceinline__ void done(const Unit&) const {}
};


DI void stage_rstd(LAS unsigned char* lds0, const float* stats, int row0) {
    int tid = threadIdx.x; asm volatile("" : "+v"(tid));
    const f32x4* q = (const f32x4*)(stats + (size_t)(row0 + (tid >> 1)) * 16 + (tid & 1) * 8); const f32x4 a = q[0], b = q[1];
    float s = ((a[0] + a[1]) + (a[2] + a[3])) + ((b[0] + b[1]) + (b[2] + b[3]));
    s += __shfl_xor(s, 1);
    if ((tid & 1) == 0) ((LAS float*)(lds0 + EPI_RS))[tid >> 1] = rsqrtf(s * (1.0f / 1024.0f) + EPS);
}
#define EPI_BARRIER() do { asm volatile("s_waitcnt lgkmcnt(0)" ::: "memory"); __builtin_amdgcn_s_barrier(); asm volatile("" ::: "memory"); } while (0)

DI u32x4 xpose_fwd(u32x4 w, int lane) { const int src = ((((lane & 3) << 4) | (lane >> 2)) << 2); u32x4 o;
    o.x = (unsigned)__builtin_amdgcn_ds_bpermute(src, (int)w.x); o.y = (unsigned)__builtin_amdgcn_ds_bpermute(src, (int)w.y); o.z = (unsigned)__builtin_amdgcn_ds_bpermute(src, (int)w.z); o.w = (unsigned)__builtin_amdgcn_ds_bpermute(src, (int)w.w); return o; }
DI u32x4 xpose_inv(u32x4 w, int lane) { const int src = ((((lane & 15) << 2) | (lane >> 4)) << 2); u32x4 o;
    o.x = (unsigned)__builtin_amdgcn_ds_bpermute(src, (int)w.x); o.y = (unsigned)__builtin_amdgcn_ds_bpermute(src, (int)w.y); o.z = (unsigned)__builtin_amdgcn_ds_bpermute(src, (int)w.z); o.w = (unsigned)__builtin_amdgcn_ds_bpermute(src, (int)w.w); return o; }

struct EpiProj {
    static constexpr bool PERM = true, AFTER_DRAIN = false;
    bf16_t* O; int ldc; const float* stats; const float* gains; int mode; LAS unsigned char* lds0;
    DI void cfg(int pn, int bj, int& gi, float& mult) const {
        gi = -1; mult = 1.f;
        if (mode == 0) {
            if (pn <= 1) { gi = 0; mult = QSCALE; }
            else if (pn == 2) { if (bj == 0) gi = 1; }
            else if (pn == 3) { gi = 2; mult = QSCALE; }
            else if (pn == 4) { gi = 3; }
            else if (pn == 6) { gi = 4; mult = QSCALE; }
        } else { if (pn == 0) gi = 5; else if (pn == 2) gi = 11; }
    }
    DI void operator()(const f32x4 (&acc)[2][2][4][2], const Unit& u, int wr, int wc, int fr, int fq) const {
        stage_rstd(lds0, stats, u.pm * BM);
        LAS float* P = (LAS float*)(lds0 + EPI_P); const LAS float* rs = (const LAS float*)(lds0 + EPI_RS);
#pragma unroll
        for (int ai = 0; ai < 2; ++ai)
#pragma unroll
            for (int m = 0; m < 4; ++m)
#pragma unroll
                for (int bj = 0; bj < 2; ++bj) {
                    float s = dot4(acc[ai][bj][m][0]) + dot4(acc[ai][bj][m][1]);
                    s += __shfl_xor(s, 16); s += __shfl_xor(s, 32);
                    if (fq == 0) P[(bj * 256 + ai * HALF + wr * 64 + m * 16 + fr) * 4 + wc] = s;
                }
        EPI_BARRIER();
#pragma unroll
        for (int bj = 0; bj < 2; ++bj) {
            int gi; float mult; cfg(u.pn, bj, gi, mult);
            f32x4 g0 = {1.f, 1.f, 1.f, 1.f}, g1 = {1.f, 1.f, 1.f, 1.f};
            if (gi >= 0) { const float* gp = gains + gi * 64 + (wc & 1) * 32 + 8 * fq; g0 = *(const f32x4*)gp; g1 = *(const f32x4*)(gp + 4); }
#pragma unroll
            for (int ai = 0; ai < 2; ++ai)
#pragma unroll
                for (int m = 0; m < 4; ++m) {
                    const int rl = ai * HALF + wr * 64 + m * 16 + fr; const float rstd = rs[rl]; float sc = rstd;
                    if (gi >= 0) { const int pi = (bj * 256 + rl) * 4 + (wc & 2); const float tot = P[pi] + P[pi + 1]; sc = rstd * rsqrtf(tot * rstd * rstd * (1.0f / 64.0f) + EPS) * mult; }
                    const f32x4 v0 = acc[ai][bj][m][0] * sc * g0, v1 = acc[ai][bj][m][1] * sc * g1;
                    u32x4 w; w.x = pk_bf16(v0[0], v0[1]); w.y = pk_bf16(v0[2], v0[3]); w.z = pk_bf16(v1[0], v1[1]); w.w = pk_bf16(v1[2], v1[3]);
                    { const int ln = fq * 16 + fr; *(u32x4*)(O + (size_t)(u.pm * BM + rl - fr + (ln >> 2)) * ldc + u.pn * BM + bj * HALF + wc * 32 + 8 * (ln & 3)) = xpose_fwd(w, ln); }
                    if (m & 1) asm volatile("" ::: "memory");
                }
        }
    }
};

struct EpiRes {
    static constexpr bool PERM = true, AFTER_DRAIN = false;
    bf16_t* xb; float* outf; const float* rstats; float* wstats; LAS unsigned char* lds0;
    DI void operator()(const f32x4 (&acc)[2][2][4][2], const Unit& u, int wr, int wc, int fr, int fq) const {
        const LAS float* rs = (const LAS float*)(lds0 + EPI_RS);
        if (rstats) { stage_rstd(lds0, rstats, u.pm * BM); EPI_BARRIER(); }
        const int col0 = u.pn * BM + wc * 32 + 8 * fq;
#pragma unroll
        for (int ai = 0; ai < 2; ++ai)
#pragma unroll
            for (int m = 0; m < 4; ++m) {
                const int rl = ai * HALF + wr * 64 + m * 16 + fr; const size_t grow = (size_t)(u.pm * BM + rl);
                float sc = 1.0f; if (rstats) { const float r_ = rs[rl]; sc = r_ * r_; }
                float ss = 0.f;
#pragma unroll
                for (int bj = 0; bj < 2; ++bj) {
                    const int c = col0 + bj * HALF;
                    const int ln = fq * 16 + fr; const size_t grow2 = grow - fr + (ln >> 2); const int c2 = u.pn * BM + wc * 32 + bj * HALF + 8 * (ln & 3);
                    const u32x4 b = xpose_inv(*(const u32x4*)(xb + grow2 * DM + c2), ln);
                    const f32x4 b0 = {bf_lo(b.x), bf_hi(b.x), bf_lo(b.y), bf_hi(b.y)}, b1 = {bf_lo(b.z), bf_hi(b.z), bf_lo(b.w), bf_hi(b.w)};
                    const f32x4 v0 = acc[ai][bj][m][0] * sc + b0, v1 = acc[ai][bj][m][1] * sc + b1;
                    if (outf) { const u32x4 t0 = xpose_fwd(__builtin_bit_cast(u32x4, v0), ln), t1 = xpose_fwd(__builtin_bit_cast(u32x4, v1), ln);
                                *(u32x4*)(outf + grow2 * DM + c2) = t0; *(u32x4*)(outf + grow2 * DM + c2 + 4) = t1; }
                    else { u32x4 w; w.x = pk_bf16(v0[0], v0[1]); w.y = pk_bf16(v0[2], v0[3]); w.z = pk_bf16(v1[0], v1[1]); w.w = pk_bf16(v1[2], v1[3]); *(u32x4*)(xb + grow2 * DM + c2) = xpose_fwd(w, ln); }
                    ss += dot4(v0) + dot4(v1);
                }
                if (!outf) { ss += __shfl_xor(ss, 16); ss += __shfl_xor(ss, 32); if (fq == 0) wstats[grow * 16 + u.pn * 4 + wc] = ss; }
                if (m & 1) asm volatile("" ::: "memory");
            }
    }
};

struct EpiFF1 {
    static constexpr bool PERM = true, AFTER_DRAIN = false;
    bf16_t* O;
    DI void operator()(const f32x4 (&acc)[2][2][4][2], const Unit& u, int wr, int wc, int fr, int fq) const {
#pragma unroll
        for (int ai = 0; ai < 2; ++ai)
#pragma unroll
            for (int m = 0; m < 4; ++m) {
                const int rl = ai * HALF + wr * 64 + m * 16 + fr;
#pragma unroll
                for (int bj = 0; bj < 2; ++bj) {
                    f32x4 v0 = acc[ai][bj][m][0], v1 = acc[ai][bj][m][1];
#pragma unroll
                    for (int e = 0; e < 4; ++e) { const float a = fmaxf(v0[e], 0.f), b = fmaxf(v1[e], 0.f); v0[e] = a * a; v1[e] = b * b; }
                    u32x4 w; w.x = pk_bf16(v0[0], v0[1]); w.y = pk_bf16(v0[2], v0[3]); w.z = pk_bf16(v1[0], v1[1]); w.w = pk_bf16(v1[2], v1[3]);
                    { const int ln = fq * 16 + fr; __builtin_nontemporal_store(xpose_fwd(w, ln), (u32x4*)(O + (size_t)(u.pm * BM + rl - fr + (ln >> 2)) * DFF + u.pn * BM + wc * 64 + bj * 32 + 8 * (ln & 3))); }
                }
            }
    }
};

template <class Epi, class Sched, bool ALIGN_EPI = false, bool SP2 = false>
__device__ __forceinline__ void gemm_phase(LAS unsigned char* lds, const Gemm g, const Sched& S, const Epi& E) {
    int tid_ = threadIdx.x; asm volatile("" : "+v"(tid_));
    const int tid = tid_, wid = __builtin_amdgcn_readfirstlane(tid >> 6), lane = tid & 63, wr = wid >> 2, wc = wid & 3, fr = lane & 15, fq = lane >> 4;
    const int K = g.K, nt = K / BK;
    unsigned voffA[2], voffB[2];
#pragma unroll
    for (int i = 0; i < 2; ++i) { int R, C; stage_rc(tid * 16 + i * 8192, R, C); const int Rb = Epi::PERM ? ((R & ~31) + perm32(R & 31)) : R;
        voffA[i] = (unsigned)(R * K + C) * 2u; voffB[i] = (unsigned)(Rb * K + C) * 2u; }
    const size_t kstep = (size_t)(BK * 2);
    const size_t hstep = (size_t)HALF * K * 2;
    const size_t tstep = 2 * hstep;
    const unsigned ldsw = (unsigned)wid * 1024u;
    const int aoff = lds_byte(wr * 64 + fr, fq * 8), boff = lds_byte(wc * 32 + fr, fq * 8);
#define PG8_SA(b, h) (((b) * 2 + (h)) * HTB)
#define PG8_SB(b, h) ((4 + (b) * 2 + (h)) * HTB)
#define PG8_STAGE(bufoff, gbase, voff) do { _Pragma("unroll") for (int _i = 0; _i < 2; ++_i) \
        __builtin_amdgcn_global_load_lds((const unsigned*)((const char*)(gbase) + (voff)[_i]), (LAS unsigned*)(lds + (bufoff) + ldsw + _i * 8192), 16, 0, 0); } while (0)
#define PG8_LDA(dst, b, h) do { _Pragma("unroll") for (int m = 0; m < 4; ++m) _Pragma("unroll") for (int k = 0; k < 2; ++k) dst[m][k] = *(const LAS bf16x8*)(lds + PG8_SA(b, h) + aoff + m * 2048 + k * 1024); } while (0)
#define PG8_LDB(dst, b, h) do { _Pragma("unroll") for (int n = 0; n < 2; ++n) _Pragma("unroll") for (int k = 0; k < 2; ++k) dst[n][k] = *(const LAS bf16x8*)(lds + PG8_SB(b, h) + boff + n * 2048 + k * 1024); } while (0)
#define PG8_MMA(ai, bj, At, Bt) do { __builtin_amdgcn_s_setprio(1); _Pragma("unroll") for (int m = 0; m < 4; ++m) _Pragma("unroll") for (int n = 0; n < 2; ++n) _Pragma("unroll") for (int k = 0; k < 2; ++k) \
        acc[ai][bj][m][n] = __builtin_amdgcn_mfma_f32_16x16x32_bf16(Bt[n][k], At[m][k], acc[ai][bj][m][n], 0, 0, 0); __builtin_amdgcn_s_setprio(0); } while (0)
#define PG8_WAIT_V(n) asm volatile("s_waitcnt vmcnt(" #n ")" ::: "memory")
#define PG8_WAIT_L(n) asm volatile("s_waitcnt lgkmcnt(" #n ")" ::: "memory")
#define PG8_BAR __builtin_amdgcn_s_barrier()
#define PG8_SCHED __builtin_amdgcn_sched_barrier(0)
    Unit cur, nxt; int ui = 0;
    if (!S.next(0, cur)) return;
    f32x4 acc[2][2][4][2];
#pragma unroll
    for (int a = 0; a < 2; ++a)
#pragma unroll
        for (int b = 0; b < 2; ++b)
#pragma unroll
            for (int m = 0; m < 4; ++m)
#pragma unroll
                for (int n = 0; n < 2; ++n) acc[a][b][m][n] = (f32x4){0.f, 0.f, 0.f, 0.f};
    bf16x8 At[4][2], B0[2][2], B1[2][2];
    const char* cA = (const char*)g.A + (size_t)cur.pm * tstep; const char* cB = (const char*)g.Bt + (size_t)cur.pn * tstep;
    S.a_ready(cur);
    if constexpr (SP2) {
        PG8_STAGE(PG8_SB(0, 0), cB, voffB); PG8_STAGE(PG8_SB(0, 1), cB + hstep, voffB); PG8_STAGE(PG8_SA(0, 0), cA, voffA); PG8_STAGE(PG8_SA(0, 1), cA + hstep, voffA);
        if (wr == 1) PG8_BAR;
        PG8_WAIT_V(2); PG8_BAR;
        PG8_STAGE(PG8_SB(1, 0), cB + kstep, voffB); PG8_STAGE(PG8_SA(1, 0), cA + kstep, voffA); PG8_STAGE(PG8_SB(1, 1), cB + hstep + kstep, voffB);
        PG8_WAIT_V(6); PG8_BAR;
    } else {
        PG8_STAGE(PG8_SB(0, 0), cB, voffB); PG8_STAGE(PG8_SA(0, 0), cA, voffA); PG8_STAGE(PG8_SB(0, 1), cB + hstep, voffB); PG8_STAGE(PG8_SA(0, 1), cA + hstep, voffA);
        if (wr == 1) PG8_BAR;
        PG8_WAIT_V(4); PG8_BAR;
        PG8_STAGE(PG8_SB(1, 0), cB + kstep, voffB); PG8_STAGE(PG8_SA(1, 0), cA + kstep, voffA); PG8_STAGE(PG8_SB(1, 1), cB + hstep + kstep, voffB);
        PG8_WAIT_V(6); PG8_BAR;
    }
    for (;;) {
        const bool has_next = S.next(ui + 1, nxt);
        const char* nA = has_next ? (const char*)g.A + (size_t)nxt.pm * tstep : cA; const char* nB = has_next ? (const char*)g.Bt + (size_t)nxt.pn * tstep : cB;
        for (int t = 0; t < nt; t += 2) {
            const bool last = (t == nt - 2);
            const char* a1 = cA + (size_t)(t + 1) * kstep;
            const char* a2 = last ? nA : cA + (size_t)(t + 2) * kstep; const char* b2 = last ? nB : cB + (size_t)(t + 2) * kstep;
            const char* a3 = a2 + kstep; const char* b3 = b2 + kstep;
            if (last && has_next) S.a_ready(nxt);
            if constexpr (SP2) {
            PG8_LDB(B0, 0, 0); PG8_LDB(B1, 0, 1); PG8_SCHED; PG8_LDA(At, 0, 0); PG8_STAGE(PG8_SA(1, 1), a1 + hstep, voffA);
            PG8_WAIT_V(8); PG8_WAIT_L(0); PG8_BAR; PG8_MMA(0, 0, At, B0); PG8_MMA(0, 1, At, B1); PG8_BAR; PG8_SCHED;
            PG8_LDA(At, 0, 1); PG8_STAGE(PG8_SB(0, 0), b2, voffB); PG8_STAGE(PG8_SB(0, 1), b2 + hstep, voffB); PG8_STAGE(PG8_SA(0, 0), a2, voffA);
            PG8_WAIT_V(8); PG8_WAIT_L(0); PG8_BAR; PG8_MMA(1, 0, At, B0); PG8_MMA(1, 1, At, B1); PG8_BAR; PG8_SCHED;
            PG8_LDB(B0, 1, 0); PG8_LDB(B1, 1, 1); PG8_SCHED; PG8_LDA(At, 1, 0); PG8_STAGE(PG8_SA(0, 1), a2 + hstep, voffA);
            PG8_WAIT_V(8); PG8_WAIT_L(0); PG8_BAR; PG8_MMA(0, 0, At, B0); PG8_MMA(0, 1, At, B1); PG8_BAR; PG8_SCHED;
            PG8_LDA(At, 1, 1); PG8_STAGE(PG8_SB(1, 0), b3, voffB); PG8_STAGE(PG8_SB(1, 1), b3 + hstep, voffB); PG8_STAGE(PG8_SA(1, 0), a3, voffA);
            PG8_WAIT_V(8); PG8_WAIT_L(0); PG8_BAR; PG8_MMA(1, 0, At, B0); PG8_MMA(1, 1, At, B1); PG8_BAR; PG8_SCHED;
            } else {
            PG8_LDB(B0, 0, 0); PG8_SCHED; PG8_LDA(At, 0, 0); PG8_STAGE(PG8_SA(1, 1), a1 + hstep, voffA);
            PG8_WAIT_L(8); PG8_BAR; PG8_WAIT_L(0); PG8_MMA(0, 0, At, B0); PG8_BAR; PG8_SCHED;
            PG8_LDB(B1, 0, 1); PG8_STAGE(PG8_SB(0, 0), b2, voffB);
            PG8_BAR; PG8_WAIT_L(0); PG8_MMA(0, 1, At, B1); PG8_BAR;
            PG8_LDA(At, 0, 1); PG8_STAGE(PG8_SA(0, 0), a2, voffA);
            PG8_BAR; PG8_WAIT_L(0); PG8_MMA(1, 0, At, B0); PG8_BAR; PG8_SCHED;
            PG8_STAGE(PG8_SB(0, 1), b2 + hstep, voffB);
            PG8_WAIT_V(6); PG8_BAR; PG8_MMA(1, 1, At, B1); PG8_BAR;
            PG8_LDB(B0, 1, 0); PG8_SCHED; PG8_LDA(At, 1, 0); PG8_STAGE(PG8_SA(0, 1), a2 + hstep, voffA);
            PG8_WAIT_L(8); PG8_BAR; PG8_WAIT_L(0); PG8_MMA(0, 0, At, B0); PG8_BAR; PG8_SCHED;
            PG8_LDB(B1, 1, 1); PG8_STAGE(PG8_SB(1, 0), b3, voffB);
            PG8_BAR; PG8_WAIT_L(0); PG8_MMA(0, 1, At, B1); PG8_BAR;
            PG8_LDA(At, 1, 1); PG8_STAGE(PG8_SA(1, 0), a3, voffA);
            PG8_BAR; PG8_WAIT_L(0); PG8_MMA(1, 0, At, B0); PG8_BAR; PG8_SCHED;
            PG8_STAGE(PG8_SB(1, 1), b3 + hstep, voffB);
            PG8_WAIT_V(6); PG8_BAR; PG8_MMA(1, 1, At, B1); PG8_BAR;
            }
        }
        if constexpr (ALIGN_EPI) { if (wr == 0) PG8_BAR; }
        if constexpr (!Epi::AFTER_DRAIN) { E(acc, cur, wr, wc, fr, fq); S.done(cur); }
        if (!has_next) break;
#pragma unroll
        for (int a = 0; a < 2; ++a)
#pragma unroll
            for (int b = 0; b < 2; ++b)
#pragma unroll
                for (int m = 0; m < 4; ++m)
#pragma unroll
                    for (int n = 0; n < 2; ++n) acc[a][b][m][n] = (f32x4){0.f, 0.f, 0.f, 0.f};
        cur = nxt; cA = nA; cB = nB; ++ui;
        if constexpr (ALIGN_EPI) { if (wr == 1) PG8_BAR; }
    }
    PG8_WAIT_V(0);
    if constexpr (!ALIGN_EPI) { if (wr == 0) PG8_BAR; }
    PG8_BAR;
#undef PG8_SA
#undef PG8_SB
#undef PG8_STAGE
#undef PG8_LDA
#undef PG8_LDB
#undef PG8_MMA
#undef PG8_WAIT_V
#undef PG8_WAIT_L
#undef PG8_BAR
#undef PG8_SCHED
}
}

namespace att {
constexpr int KSTR = 528, VSTR = 576;
constexpr int L_K = 0, L_V = 64 * KSTR, L_O = 64 * KSTR + 64 * VSTR, OSTR = 1040, L_WS = L_O + 64 * OSTR, L_RPB = L_WS + 2048 + 512, L_CST = L_RPB + 7440 + 512, L_ALIBI = L_CST + 64, NAL = 416, L_END = L_ALIBI + 8 * NAL * 4;
constexpr int PITCH = INW;
#define MFMA32(a, b, c) __builtin_amdgcn_mfma_f32_32x32x16_bf16((a), (b), (c), 0, 0, 0)
typedef short v4i16_t __attribute__((ext_vector_type(4)));
DI s16x4 vtr(const LAS unsigned char* p) { return __builtin_bit_cast(s16x4, __builtin_amdgcn_ds_read_tr16_b64_v4i16((LAS v4i16_t*)p)); }

struct Args { const bf16_t* proj; const bf16_t* memkv; bf16_t* o; const float* sink; const float* rpb; const float* gains; int layer; };

template <int W> DI void tile_gload(u32x4 (&kr)[4], u32x4 (&vr)[4], const bf16_t* Kg, const bf16_t* Vg, int pitch, int tid) {
    constexpr int CPR = W / 8, NC = (64 * CPR) / 512;
#pragma unroll
    for (int c = 0; c < NC; ++c) { const int idx = tid + 512 * c, row = idx / CPR, ch = idx % CPR;
        kr[c] = *(const u32x4*)(Kg + (size_t)row * pitch + ch * 8); vr[c] = *(const u32x4*)(Vg + (size_t)row * pitch + ch * 8); }
}
template <int W> DI void tile_lstore(LAS unsigned char* lds, const u32x4 (&kr)[4], const u32x4 (&vr)[4], int tid) {
    constexpr int CPR = W / 8, NC = (64 * CPR) / 512;
#pragma unroll
    for (int c = 0; c < NC; ++c) { const int idx = tid + 512 * c, row = idx / CPR, ch = idx % CPR;
        *(LAS u32x4*)(lds + L_K + row * KSTR + ch * 16) = kr[c]; *(LAS u32x4*)(lds + L_V + row * VSTR + ch * 16) = vr[c]; }
}

template <int TYPE, int SUBS = 3> DI void tile_compute(LAS unsigned char* lds, const bf16x8 (&qf)[4], float& l, f32x16& o0, f32x16& o1,
                                         int hcolb, int lane, const LAS float* tab_lane, int e0, float negc) {
    const int r = lane & 31, h = lane >> 5;
    f32x16 p0, p1;
    if (TYPE == 2) {
#pragma unroll
        for (int i = 0; i < 16; ++i) { p0[i] = negc; p1[i] = negc; }
    } else {
#pragma unroll
        for (int i = 0; i < 16; ++i) { const int c = (i & 3) + 8 * (i >> 2); p0[i] = (SUBS & 1) ? tab_lane[c] : 0.f; p1[i] = (SUBS & 2) ? tab_lane[c + 32] : 0.f; }
    }
    const LAS unsigned char* kb = lds + L_K + r * KSTR + hcolb + 16 * h;
#pragma unroll
    for (int ds = 0; ds < 4; ++ds) {
        if (SUBS & 1) { const bf16x8 k0 = *(const LAS bf16x8*)(kb + ds * 32); p0 = MFMA32(k0, qf[ds], p0); }
        if (SUBS & 2) { const bf16x8 k1 = *(const LAS bf16x8*)(kb + 32 * KSTR + ds * 32); p1 = MFMA32(k1, qf[ds], p1); }
    }
    float sum = 0.f;
#pragma unroll
    for (int i = 0; i < 16; ++i) {
        if (SUBS & 1) { p0[i] = __builtin_amdgcn_exp2f(p0[i]); sum += p0[i]; }
        if (SUBS & 2) { p1[i] = __builtin_amdgcn_exp2f(p1[i]); sum += p1[i]; } }
    l += sum;
    bf16x8 pa[4];
#pragma unroll
    for (int s = 0; s < 2; ++s) {
        u32x4 w0, w1;
        w0.x = pk_bf16(p0[8 * s + 0], p0[8 * s + 1]); w0.y = pk_bf16(p0[8 * s + 2], p0[8 * s + 3]); w0.z = pk_bf16(p0[8 * s + 4], p0[8 * s + 5]); w0.w = pk_bf16(p0[8 * s + 6], p0[8 * s + 7]);
        w1.x = pk_bf16(p1[8 * s + 0], p1[8 * s + 1]); w1.y = pk_bf16(p1[8 * s + 2], p1[8 * s + 3]); w1.z = pk_bf16(p1[8 * s + 4], p1[8 * s + 5]); w1.w = pk_bf16(p1[8 * s + 6], p1[8 * s + 7]);
        pa[s] = __builtin_bit_cast(bf16x8, w0); pa[2 + s] = __builtin_bit_cast(bf16x8, w1);
    }
    const int i16 = lane & 15, q4 = i16 >> 2, pp = i16 & 3, blk = (lane >> 4) & 1;
    const LAS unsigned char* vb = lds + L_V + (4 * h + q4) * VSTR + hcolb + 32 * blk + 8 * pp;
#pragma unroll
    for (int s = 0; s < 4; ++s) {
        if (!((SUBS >> (s >> 1)) & 1)) continue;
        const s16x4 lo0 = vtr(vb + (16 * s) * VSTR), hi0 = vtr(vb + (16 * s + 8) * VSTR);
        const s16x4 lo1 = vtr(vb + (16 * s) * VSTR + 64), hi1 = vtr(vb + (16 * s + 8) * VSTR + 64);
        const bf16x8 v0 = __builtin_shufflevector(lo0, hi0, 0, 1, 2, 3, 4, 5, 6, 7), v1 = __builtin_shufflevector(lo1, hi1, 0, 1, 2, 3, 4, 5, 6, 7);
        o0 = MFMA32(pa[s], v0, o0); o1 = MFMA32(pa[s], v1, o1);
    }
}

template <int HALF> DI void tile_compute_b(LAS unsigned char* lds, const bf16x8 (&qf)[4], float& l, f32x16& o0, f32x16& o1,
                                           int hcolb, int lane, const LAS float* tab_lane, int e0) {
    const int r = lane & 31, h = lane >> 5;
    f32x16 p0, p1;
#pragma unroll
    for (int i = 0; i < 16; ++i) { const int c = (i & 3) + 8 * (i >> 2);
        p0[i] = (HALF == 0 || i >= 12) ? tab_lane[c] : 0.f; p1[i] = (HALF == 1 || i < 4) ? tab_lane[c + 32] : 0.f; }
    const LAS unsigned char* kb = lds + L_K + r * KSTR + hcolb + 16 * h;
#pragma unroll
    for (int ds = 0; ds < 4; ++ds) {
        const bf16x8 k0 = *(const LAS bf16x8*)(kb + ds * 32);
        const bf16x8 k1 = *(const LAS bf16x8*)(kb + 32 * KSTR + ds * 32);
        p0 = MFMA32(k0, qf[ds], p0); p1 = MFMA32(k1, qf[ds], p1);
    }
    float sum = 0.f;
#pragma unroll
    for (int i = 0; i < 16; ++i) { const int c = (i & 3) + 8 * (i >> 2);
        if (HALF == 0 || i >= 12) { p0[i] = __builtin_amdgcn_exp2f(((unsigned)(e0 + c) < 16u) ? p0[i] : -INFINITY); sum += p0[i]; } else p0[i] = 0.f;
        if (HALF == 1 || i < 4) { p1[i] = __builtin_amdgcn_exp2f(((unsigned)(e0 + c + 32) < 16u) ? p1[i] : -INFINITY); sum += p1[i]; } else p1[i] = 0.f; }
    l += sum;
    bf16x8 pa[4];
#pragma unroll
    for (int s = 0; s < 2; ++s) {
        u32x4 w0, w1;
        w0.x = pk_bf16(p0[8 * s + 0], p0[8 * s + 1]); w0.y = pk_bf16(p0[8 * s + 2], p0[8 * s + 3]); w0.z = pk_bf16(p0[8 * s + 4], p0[8 * s + 5]); w0.w = pk_bf16(p0[8 * s + 6], p0[8 * s + 7]);
        w1.x = pk_bf16(p1[8 * s + 0], p1[8 * s + 1]); w1.y = pk_bf16(p1[8 * s + 2], p1[8 * s + 3]); w1.z = pk_bf16(p1[8 * s + 4], p1[8 * s + 5]); w1.w = pk_bf16(p1[8 * s + 6], p1[8 * s + 7]);
        pa[s] = __builtin_bit_cast(bf16x8, w0); pa[2 + s] = __builtin_bit_cast(bf16x8, w1);
    }
    const int i16 = lane & 15, q4 = i16 >> 2, pp = i16 & 3, blk = (lane >> 4) & 1;
    const LAS unsigned char* vb = lds + L_V + (4 * h + q4) * VSTR + hcolb + 32 * blk + 8 * pp;
#pragma unroll
    for (int s = 0; s < 4; ++s) {
        if ((HALF == 0 && s == 3) || (HALF == 1 && s == 0)) continue;
        const s16x4 lo0 = vtr(vb + (16 * s) * VSTR), hi0 = vtr(vb + (16 * s + 8) * VSTR);
        const s16x4 lo1 = vtr(vb + (16 * s) * VSTR + 64), hi1 = vtr(vb + (16 * s + 8) * VSTR + 64);
        const bf16x8 v0 = __builtin_shufflevector(lo0, hi0, 0, 1, 2, 3, 4, 5, 6, 7), v1 = __builtin_shufflevector(lo1, hi1, 0, 1, 2, 3, 4, 5, 6, 7);
        o0 = MFMA32(pa[s], v0, o0); o1 = MFMA32(pa[s], v1, o1);
    }
}

DI void write_ost(LAS unsigned char* lds, LAS float* wsf, float l, const f32x16& o0, const f32x16& o1, int rt, int ocol, int lane) {
    const int r = lane & 31, h = lane >> 5;
    const float lt = l + __shfl_xor(l, 32);
    if (h == 0) wsf[r] = 1.0f / lt;
    asm volatile("s_waitcnt lgkmcnt(0)" ::: "memory");
#pragma unroll
    for (int g = 0; g < 4; ++g) { const f32x4 a = *(const LAS f32x4*)(wsf + 8 * g + 4 * h);
#pragma unroll
        for (int j = 0; j < 4; ++j) { const int i = 4 * g + j, row = 32 * rt + j + 8 * g + 4 * h;
            LAS bf16_t* op = (LAS bf16_t*)(lds + L_O + row * OSTR) + ocol + r;
            op[0] = (bf16_t)(pk_bf16(o0[i] * a[j], 0.f) & 0xffffu); op[32] = (bf16_t)(pk_bf16(o1[i] * a[j], 0.f) & 0xffffu); } }
    asm volatile("s_waitcnt lgkmcnt(0)" ::: "memory");
}
template <int NC> DI void finalize(LAS unsigned char* lds, bf16_t* o, int row0, int gcol, int tid) {
    __syncthreads();
    const int token = tid >> 3, c8 = tid & 7;
    u32x4 v[NC / 64]; float ss = 0.f;
#pragma unroll
    for (int j = 0; j < NC / 64; ++j) { v[j] = *(const LAS u32x4*)(lds + L_O + token * OSTR + (64 * j + 8 * c8) * 2);
#pragma unroll
        for (int e = 0; e < 4; ++e) { const float a = bf_lo(v[j][e]), b = bf_hi(v[j][e]); ss += a * a + b * b; } }
    ss += __shfl_xor(ss, 1); ss += __shfl_xor(ss, 2); ss += __shfl_xor(ss, 4);
    const float rstd = rsqrtf(ss * (1.0f / NC) + EPS);
#pragma unroll
    for (int j = 0; j < NC / 64; ++j) { u32x4 w;
#pragma unroll
        for (int e = 0; e < 4; ++e) w[e] = pk_bf16(bf_lo(v[j][e]) * rstd, bf_hi(v[j][e]) * rstd);
        __builtin_nontemporal_store(w, (u32x4*)(o + (size_t)(row0 + token) * DM + gcol + 64 * j + 8 * c8)); }
}

DI void load_q(bf16x8 (&qf)[4], const bf16_t* p) {
#pragma unroll
    for (int ds = 0; ds < 4; ++ds) qf[ds] = *(const bf16x8*)(p + 16 * ds);
}

DI void attn_unit(LAS unsigned char* lds, const Args& a, int u) {
    int tid_ = threadIdx.x; asm volatile("" : "+v"(tid_));
    const int tid = tid_, lane = tid & 63, wid = __builtin_amdgcn_readfirstlane(tid >> 6), r = lane & 31, h = lane >> 5;
    const int hg = wid >> 1, rt = wid & 1;
    const int row0 = u * 64;
    int S, seq_start, memrow0;
    if (row0 < NPROMPT) { S = 8192; const int b = row0 >> 13; seq_start = b << 13; memrow0 = b * 256; }
    else { S = 4096; const int b = (row0 - NPROMPT) >> 12; seq_start = NPROMPT + (b << 12); memrow0 = 2048 + b * 256; }
    const int pos0 = row0 - seq_start;
    const int R = S >> 6, rq = pos0 >> 6; int rstart = rq - 4; rstart = rstart < 0 ? 0 : rstart; rstart = rstart > R - 8 ? R - 8 : rstart;
    const bf16_t* projS = a.proj + (size_t)seq_start * PITCH;
    const bf16_t* qrow = a.proj + (size_t)(row0 + 32 * rt + r) * PITCH + 8 * h;
    LAS float* wsf = (LAS float*)(lds + L_WS) + wid * 64;
    const LAS float* rpbL = (const LAS float*)(lds + L_RPB);
    const bf16_t* memK = a.memkv + (size_t)memrow0 * DM + a.layer * 512;
    u32x4 kr[4], vr[4];
    bf16x8 qf[4]; float l; f32x16 o0, o1;
    const LAS float* cst = (const LAS float*)(lds + L_CST); const LAS float* alibiL = (const LAS float*)(lds + L_ALIBI);
#define GLOAD_A(kvh, t) do { const int tp_ = pos0 - 128 + 64 * (t); if (tp_ >= 0 && tp_ < S) tile_gload<64>(kr, vr, projS + (size_t)tp_ * PITCH + 512 + 64 * (kvh), projS + (size_t)tp_ * PITCH + 640 + 64 * (kvh), PITCH, tid); } while (0)
#define GLOAD_B(t) tile_gload<256>(kr, vr, projS + (size_t)(64 * (rstart + (t))) * PITCH + 1024, projS + (size_t)(64 * (rstart + (t))) * PITCH + 1280, PITCH, tid)
#define GLOAD_M(t) tile_gload<256>(kr, vr, memK + (size_t)(64 * (t)) * DM, memK + (size_t)(64 * (t)) * DM + 256, DM, tid)
#define ZERO_O() do { _Pragma("unroll") for (int i_ = 0; i_ < 16; ++i_) { o0[i_] = 0.f; o1[i_] = 0.f; } } while (0)
#define A_TP(t) (pos0 - 128 + 64 * (t))
#define A_OK(t) ((t) < 5 && A_TP(t) >= 0 && A_TP(t) < S)
#define A_GL(kvh, t, i) do { if (A_OK(t)) { const bf16_t* kp_ = projS + (size_t)A_TP(t) * PITCH + 512 + 64 * (kvh) + ((unsigned)tid >> 3) * (unsigned)PITCH + ((unsigned)tid & 7u) * 8u; \
        kr[i] = *(const u32x4*)kp_; vr[i] = *(const u32x4*)(kp_ + 128); } } while (0)
#define A_ST(i, cofs) do { LAS unsigned char* kd_ = lds + L_K + ((unsigned)tid >> 3) * KSTR + (cofs) + ((unsigned)tid & 7u) * 16; LAS unsigned char* vd_ = lds + L_V + ((unsigned)tid >> 3) * VSTR + (cofs) + ((unsigned)tid & 7u) * 16; \
        *(LAS u32x4*)kd_ = kr[i]; *(LAS u32x4*)vd_ = vr[i]; } while (0)
    A_GL(0, 0, 0); A_GL(0, 1, 1);
#pragma unroll 1
    for (int kvh = 0; kvh < 2; ++kvh) {
        const int head = 4 * kvh + hg;
        load_q(qf, qrow + 64 * head);
        { const float sink2 = a.sink[a.layer * 8 + head] * LOG2E; l = (h == 0) ? __builtin_amdgcn_exp2f(sink2 - fmaxf(cst[0], sink2)) : 0.0f; } ZERO_O();
        const LAS float* tl0 = alibiL + head * NAL + (4 * h - (pos0 + 32 * rt + r) + 192);
#pragma unroll 1
        for (int sp = 0; sp < 3; ++sp) {
            const int ta = 2 * sp, tb = 2 * sp + 1; const bool va = A_OK(ta), vb = A_OK(tb);
            if (va) A_ST(0, 0);
            if (vb) A_ST(1, 128);
            __syncthreads();
            if (sp < 2) { A_GL(kvh, ta + 2, 0); A_GL(kvh, tb + 2, 1); } else if (kvh == 0) { A_GL(1, 0, 0); A_GL(1, 1, 1); } else GLOAD_B(0);
            if (va) { const LAS float* tl = tl0 + A_TP(ta);
                if (ta == 4 && rt == 0) tile_compute<0, 1>(lds, qf, l, o0, o1, 0, lane, tl, 0, 0.f);
                else if (ta == 0 && rt == 1) tile_compute<0, 2>(lds, qf, l, o0, o1, 0, lane, tl, 0, 0.f);
                else tile_compute<0, 3>(lds, qf, l, o0, o1, 0, lane, tl, 0, 0.f); }
            if (vb) tile_compute<0, 3>(lds, qf, l, o0, o1, 128, lane, tl0 + A_TP(tb), 0, 0.f);
            __syncthreads();
        }
        write_ost(lds, wsf, l, o0, o1, rt, 64 * head, lane);
    }
#undef A_TP
#undef A_OK
#undef A_GL
#undef A_ST
    finalize<512>(lds, a.o, row0, 0, tid);
    {
        load_q(qf, qrow + 768 + 64 * hg);
        l = 0.f; ZERO_O();
        const int cq = 32 * rt + r; int cs = cq - 8; cs = cs < 0 ? 0 : cs; cs = cs > 48 ? 48 : cs;
        const int e0 = 4 * h - cs;
#pragma unroll 1
        for (int t = 0; t < 8; ++t) {
            tile_lstore<256>(lds, kr, vr, tid);
            __syncthreads();
            if (t < 7) GLOAD_B(t + 1); else GLOAD_M(0);
            const LAS float* rl = rpbL + hg * 465 + (rstart + t - rq + 7) * 31 + (4 * h - cq + 15);
            if (rt == 0) tile_compute_b<0>(lds, qf, l, o0, o1, 128 * hg, lane, rl, e0); else tile_compute_b<1>(lds, qf, l, o0, o1, 128 * hg, lane, rl, e0);
            __syncthreads();
        }
        write_ost(lds, wsf, l, o0, o1, rt, 64 * hg, lane);
    }
    finalize<256>(lds, a.o, row0, 512, tid);
    {
        load_q(qf, qrow + 1536 + 64 * hg);
        l = 0.f; ZERO_O();
        const float negcm = -cst[2];
#pragma unroll 1
        for (int t = 0; t < 4; ++t) {
            tile_lstore<256>(lds, kr, vr, tid);
            __syncthreads();
            if (t < 3) GLOAD_M(t + 1);
            tile_compute<2>(lds, qf, l, o0, o1, 128 * hg, lane, rpbL, 0, negcm);
            __syncthreads();
        }
        write_ost(lds, wsf, l, o0, o1, rt, 64 * hg, lane);
    }
    finalize<256>(lds, a.o, row0, 768, tid);
    __syncthreads();
#undef GLOAD_A
#undef GLOAD_B
#undef GLOAD_M
#undef ZERO_O
}

DI void attn_phase(LAS unsigned char* lds, const Args& a, int G, int bid) {
    int tid_ = threadIdx.x; asm volatile("" : "+v"(tid_)); const int tid = tid_;
    LAS float* rpbL = (LAS float*)(lds + L_RPB); LAS float* cst = (LAS float*)(lds + L_CST); LAS float* alibiL = (LAS float*)(lds + L_ALIBI);
    {
        const int wv = tid >> 6, ln = tid & 63;
        if (wv < 6) { float g = __builtin_fabsf(a.gains[wv * 64 + ln]);
#pragma unroll
            for (int o = 1; o < 64; o <<= 1) g = fmaxf(g, __shfl_xor(g, o));
            if (ln == 0) cst[8 + wv] = g; }
        __syncthreads();
        if (tid < 3) cst[tid] = 8.0f * LOG2E * cst[8 + 2 * tid] * cst[9 + 2 * tid];
        __syncthreads();
    }
    { const float cA = cst[0], cB = cst[1];
      for (int i = tid; i < 1860; i += 512) rpbL[i] = a.rpb[a.layer * 1860 + i] * LOG2E - cB;
      for (int i = tid; i < 8 * NAL; i += 512) { const int hh = i / NAL, d = i % NAL - 192, ad = d < 0 ? -d : d;
          const float sink2 = a.sink[a.layer * 8 + hh] * LOG2E, c2 = fmaxf(cA, sink2), slope2 = __builtin_amdgcn_exp2f(-(float)(hh + 1)) * LOG2E;
          alibiL[i] = (ad <= 128) ? -slope2 * (float)ad - c2 : -INFINITY; } }
    __syncthreads();
    const int nunits = NTOK / 64, upc = (nunits + G - 1) / G;
    const int vcu = (G % 8 == 0) ? (bid % 8) * (G / 8) + bid / 8 : bid;
    for (int i = 0; i < upc; ++i) { const int u = vcu * upc + i; if (u < nunits) attn_unit(lds, a, u); }
}
}

constexpr size_t MiB = 1u << 20;
constexpr size_t WS_WIN = 0, WS_WOUT = 7 * MiB, WS_WFF1 = 11 * MiB, WS_WFF2 = 27 * MiB, WS_WMEM = 43 * MiB, WS_MEMB = 45 * MiB, WS_MEMKV = 51 * MiB,
                 WS_STATS = 57 * MiB, WS_MSTATS = 62 * MiB, WS_CTL = 63 * MiB, WS_XB = 64 * MiB, WS_PROJ = 224 * MiB, WS_O = 504 * MiB, WS_HID = 224 * MiB, WS_STATS2 = 864 * MiB, WS_END = 869 * MiB;
constexpr int LDS_BYTES = 160 * 1024, LDS_BARW = LDS_BYTES - 64, CTL_BYTES = 16384;
static_assert(att::L_END <= LDS_BYTES && pg8::EPI_P + 8192 <= LDS_BYTES, "LDS map");

struct Params {
    const float *x_prompt, *x_sample, *mem_prompt, *mem_sample, *g_mix, *w_in, *qk_gain, *sink, *rpb, *o_gain, *w_out, *g_mem, *w_mem_kv, *g_ff, *w_ff1, *w_ff2;
    float* out; unsigned char* ws;
};

DI float wave_sum(float v) {
#pragma unroll
    for (int o = 1; o < 64; o <<= 1) v += __shfl_xor(v, o);
    return v;
}
DI void transpose_item(const float* W, const float* g, int K, int N, bf16_t* WT, LAS float* scr, int item, int lane, bool permk = false) {
    const int nblk = N / 32, kb = item / nblk, nb = item % nblk, k0 = 64 * kb, n0 = 32 * nb;
    float wv[32];
#pragma unroll
    for (int i = 0; i < 32; ++i) { const int kk = 2 * i + (lane >> 5); wv[i] = W[(size_t)(k0 + kk) * N + n0 + (lane & 31)]; }
    const float gl = g ? g[k0 + lane] : 1.0f;
#pragma unroll
    for (int i = 0; i < 32; ++i) { const int kk = 2 * i + (lane >> 5); scr[kk * 33 + (lane & 31)] = wv[i] * __shfl(gl, kk); }
    asm volatile("s_waitcnt lgkmcnt(0)" ::: "memory");
    const int c = lane & 7;
#pragma unroll
    for (int j = 0; j < 4; ++j) { const int n = (lane >> 3) + 8 * j; const LAS float* s = scr + (8 * c) * 33 + n;
        u32x4 o; o.x = pk_bf16(s[0 * 33], s[1 * 33]); o.y = pk_bf16(s[2 * 33], s[3 * 33]); o.z = pk_bf16(s[4 * 33], s[5 * 33]); o.w = pk_bf16(s[6 * 33], s[7 * 33]);
        int kd = k0 + 8 * c;
        if (permk) { const int lb = kd & 255; kd = (kd & ~255) + ((lb >> 5) & 3) * 64 + (lb >> 7) * 32 + (lb & 31); }
        *(u32x4*)(WT + (size_t)(n0 + n) * K + kd) = o; }
    asm volatile("s_waitcnt lgkmcnt(0)" ::: "memory");
}
DI void rows4_to_bf16(const float* xrow, bf16_t* orow, float* st, int lane) {
    f32x4 v[4][4]; float s[4];
#pragma unroll
    for (int r = 0; r < 4; ++r)
#pragma unroll
        for (int j = 0; j < 4; ++j) v[r][j] = *((const f32x4*)(xrow + (size_t)r * DM) + lane + 64 * j);
#pragma unroll
    for (int r = 0; r < 4; ++r) { s[r] = (dot4(v[r][0]) + dot4(v[r][1])) + (dot4(v[r][2]) + dot4(v[r][3])); }
#pragma unroll
    for (int o = 1; o < 64; o <<= 1) {
#pragma unroll
        for (int r = 0; r < 4; ++r) s[r] += __shfl_xor(s[r], o);
    }
#pragma unroll
    for (int r = 0; r < 4; ++r) {
        u32x2* o8 = (u32x2*)(orow + (size_t)r * DM) + lane;
#pragma unroll
        for (int j = 0; j < 4; ++j) { u32x2 w; w.x = pk_bf16(v[r][j][0], v[r][j][1]); w.y = pk_bf16(v[r][j][2], v[r][j][3]); o8[64 * j] = w; }
    }
    const float mine = (lane == 0) ? s[0] : (lane == 16) ? s[1] : (lane == 32) ? s[2] : (lane == 48) ? s[3] : 0.f;
    st[lane] = mine;
}
#define XB_TMO      128
#define XB_XCNT(j)  (256  + 64 * (j))
#define XB_XSUB(j)  (1280 + 64 * (j))
#define XB_XGEN(j)  (2304 + 64 * (j))
#define XB_TOP      3328
#define XB_TOPGEN   3392
#define XCD_BAR_WORDS 3456
#define XB_SPIN_CAP (1u << 18)
DI unsigned xb_ld(unsigned* p)              { return __hip_atomic_load(p, __ATOMIC_RELAXED, __HIP_MEMORY_SCOPE_AGENT); }
DI unsigned xb_add(unsigned* p, unsigned v) { return __hip_atomic_fetch_add(p, v, __ATOMIC_RELAXED, __HIP_MEMORY_SCOPE_AGENT); }
DI unsigned xb_xcc_id() { return (unsigned)__builtin_amdgcn_s_getreg((3 << 11) | 20) & 0xFu; }
#define XB_SPIN(cond, bar) do { unsigned _sp = 0; while (cond) { __builtin_amdgcn_s_sleep(1); \
    if ((++_sp & 255u) == 0u) { if (xb_ld(&(bar)[XB_TMO])) break; if (_sp > XB_SPIN_CAP) { atomicAdd(&(bar)[XB_TMO], 1u); break; } } } } while (0)
struct XcdBarrier { unsigned* bar; unsigned x; volatile LAS unsigned* st; };
DI XcdBarrier xcd_barrier_post(unsigned* bar, volatile LAS unsigned* st) {
    XcdBarrier b; b.bar = bar; b.x = xb_xcc_id(); b.st = st;
    if (threadIdx.x == 0) (void)xb_add(&bar[XB_XCNT(b.x)], 1u);
    return b;
}
DI void xcd_barrier_complete(unsigned* bar, unsigned x, unsigned& nloc, unsigned& nx) {
    const unsigned G = gridDim.x * gridDim.y * gridDim.z;
    unsigned sum, cnt, mine, sp = 0u;
    for (;;) {
        sum = 0u; cnt = 0u; mine = 0u;
#pragma unroll
        for (unsigned j = 0; j < 16; ++j) { const unsigned c = xb_ld(&bar[XB_XCNT(j)]); sum += c; cnt += (c > 0u) ? 1u : 0u; mine = (j == x) ? c : mine; }
        if (sum == G) break;
        __builtin_amdgcn_s_sleep(1);
        if ((++sp & 255u) == 0u) { if (xb_ld(&bar[XB_TMO])) break; if (sp > XB_SPIN_CAP) { atomicAdd(&bar[XB_TMO], 1u); break; } }
    }
    nloc = mine > 0u ? mine : 1u; nx = cnt > 0u ? cnt : 1u;
}
DI void xcd_barrier(const XcdBarrier& b) {
    asm volatile("s_waitcnt vmcnt(0)" ::: "memory");
    __syncthreads();
    if (threadIdx.x == 0) {
        unsigned* bar = b.bar;
        __builtin_amdgcn_s_waitcnt(0);
        unsigned nloc = b.st[0], nx = b.st[1];
        if (nloc == 0u) { xcd_barrier_complete(bar, b.x, nloc, nx); b.st[0] = nloc; b.st[1] = nx; }
        const unsigned old = xb_add(&bar[XB_XSUB(b.x)], 1u);
        const unsigned gen = old / nloc;
        if (old + 1u == (gen + 1u) * nloc) {
            __builtin_amdgcn_fence(__ATOMIC_RELEASE, "agent");
            asm volatile("s_waitcnt vmcnt(0)" ::: "memory");
            const unsigned og = xb_add(&bar[XB_TOP], 1u);
            const unsigned tg = og / nx;
            if (og + 1u == (tg + 1u) * nx) xb_add(&bar[XB_TOPGEN], 1u);
            else XB_SPIN(xb_ld(&bar[XB_TOPGEN]) == tg, bar);
            __builtin_amdgcn_fence(__ATOMIC_ACQUIRE, "agent");
            xb_add(&bar[XB_XGEN(b.x)], 1u);
            asm volatile("s_waitcnt vmcnt(0)" ::: "memory");
        } else {
            XB_SPIN(xb_ld(&bar[XB_XGEN(b.x)]) == gen, bar);
            __builtin_amdgcn_fence(__ATOMIC_ACQUIRE, "agent");
            asm volatile("s_waitcnt vmcnt(0)" ::: "memory");
        }
    }
    __syncthreads();
}

__global__ void __launch_bounds__(512, 2) fwd_megakernel(Params p) {
    extern __shared__ __attribute__((aligned(16))) unsigned char lds_raw[];
    LAS unsigned char* lds = (LAS unsigned char*)lds_raw;
    cg::grid_group grid = cg::this_grid();
    const int tid = threadIdx.x, lane = tid & 63, wave = __builtin_amdgcn_readfirstlane(tid >> 6);
    const int G = gridDim.x, bid = blockIdx.x;
    volatile LAS unsigned* barw = (volatile LAS unsigned*)(lds + LDS_BARW);
    if (tid < 2) barw[tid] = 0u;
    __syncthreads();
    XcdBarrier xbar = xcd_barrier_post((unsigned*)(p.ws + WS_CTL), barw);
    typedef const __attribute__((address_space(4))) Params* KP;
    KP kp0 = (KP)__builtin_amdgcn_kernarg_segment_ptr();
#define PHASE_PTRS() KP kp = kp0; asm volatile("" : "+s"(kp)); unsigned char* ws = kp->ws; \
    bf16_t* WIN = (bf16_t*)(ws + WS_WIN); bf16_t* WOUT = (bf16_t*)(ws + WS_WOUT); bf16_t* WFF1 = (bf16_t*)(ws + WS_WFF1); bf16_t* WFF2 = (bf16_t*)(ws + WS_WFF2); bf16_t* WMEM = (bf16_t*)(ws + WS_WMEM); \
    bf16_t* MEMB = (bf16_t*)(ws + WS_MEMB); bf16_t* MEMKV = (bf16_t*)(ws + WS_MEMKV); float* STATS = (float*)(ws + WS_STATS); float* STATS2 = (float*)(ws + WS_STATS2); float* MSTATS = (float*)(ws + WS_MSTATS); \
    bf16_t* XB = (bf16_t*)(ws + WS_XB); bf16_t* PROJ = (bf16_t*)(ws + WS_PROJ); bf16_t* OB = (bf16_t*)(ws + WS_O); bf16_t* HID = (bf16_t*)(ws + WS_HID); \
    (void)WIN; (void)WOUT; (void)WFF1; (void)WFF2; (void)WMEM; (void)MEMB; (void)MEMKV; (void)STATS; (void)STATS2; (void)MSTATS; (void)XB; (void)PROJ; (void)OB; (void)HID;

    {
        PHASE_PTRS();
        LAS float* scr = (LAS float*)(lds + wave * 16384);
        const int gw = bid * 8 + wave, NGW = G * 8;
        constexpr int I_IN = 16 * 56, I_OUT = 16 * 32, I_FF1 = 16 * 128, I_FF2 = 64 * 32, I_MEM = 16 * 16, I_L = I_IN + I_OUT + I_FF1 + I_FF2 + I_MEM;
        for (int it = gw; it < 2 * I_L; it += NGW) {
            const int l = it / I_L; int r = it % I_L;
            if (r < I_IN) { transpose_item(kp->w_in + (size_t)l * DM * INW, kp->g_mix + l * DM, DM, INW, WIN + (size_t)l * INW * DM, scr, r, lane); continue; } r -= I_IN;
            if (r < I_OUT) { transpose_item(kp->w_out + (size_t)l * DM * DM, kp->o_gain + l * DM, DM, DM, WOUT + (size_t)l * DM * DM, scr, r, lane); continue; } r -= I_OUT;
            if (r < I_FF1) { transpose_item(kp->w_ff1 + (size_t)l * DM * DFF, kp->g_ff + l * DM, DM, DFF, WFF1 + (size_t)l * DFF * DM, scr, r, lane); continue; } r -= I_FF1;
            if (r < I_FF2) { transpose_item(kp->w_ff2 + (size_t)l * DFF * DM, nullptr, DFF, DM, WFF2 + (size_t)l * DM * DFF, scr, r, lane, true); continue; } r -= I_FF2;
            transpose_item(kp->w_mem_kv + (size_t)l * DM * 512, kp->g_mem + l * DM, DM, 512, WMEM + (size_t)l * 512 * DM, scr, r, lane);
        }
        for (int m4 = gw; m4 < (NTOK + NMEMROWS) / 4; m4 += NGW) {
            const int m = m4 * 4;
            if (m < NTOK) { const float* src = (m < NPROMPT) ? kp->x_prompt + (size_t)m * DM : kp->x_sample + (size_t)(m - NPROMPT) * DM; rows4_to_bf16(src, XB + (size_t)m * DM, STATS + (size_t)m * 16, lane); }
            else { const int mm = m - NTOK; const float* src = (mm < 2048) ? kp->mem_prompt + (size_t)mm * DM : kp->mem_sample + (size_t)(mm - 2048) * DM; rows4_to_bf16(src, MEMB + (size_t)mm * DM, MSTATS + (size_t)mm * 16, lane); }
        }
    }
    grid.sync();

#pragma unroll 1
    for (int l = 0; l < 2; ++l) {
        {
            PHASE_PTRS();
            pg8::Gemm g{XB, WIN + (size_t)l * INW * DM, NTOK, INW, DM}; pg8::StaticOrder S; S.init(NTOK, INW, G, bid);
            pg8::EpiProj E{PROJ, INW, STATS, kp->qk_gain + l * 384, 0, lds};
            pg8::gemm_phase<pg8::EpiProj, pg8::StaticOrder, true, true>(lds, g, S, E);
            if (l == 0) {
                pg8::Gemm gm{MEMB, WMEM, NMEMROWS, 1024, DM}; pg8::StaticOrder Sm; Sm.init(NMEMROWS, 1024, G, (bid + 64) % G);
                pg8::EpiProj Em{MEMKV, 1024, MSTATS, kp->qk_gain, 1, lds};
                pg8::gemm_phase<pg8::EpiProj, pg8::StaticOrder, true, true>(lds, gm, Sm, Em);
            }
        }
        xcd_barrier(xbar);
        {
            PHASE_PTRS();
            att::Args a{PROJ, MEMKV, OB, kp->sink, kp->rpb, kp->qk_gain + l * 384, l};
            att::attn_phase(lds, a, G, bid);
        }
        xcd_barrier(xbar);
        {
            PHASE_PTRS();
            pg8::Gemm g{OB, WOUT + (size_t)l * DM * DM, NTOK, DM, DM}; pg8::StaticOrder S; S.init(NTOK, DM, G, bid);
            pg8::EpiRes E{XB, nullptr, nullptr, STATS2, lds};
            pg8::gemm_phase<pg8::EpiRes, pg8::StaticOrder, true, true>(lds, g, S, E);
        }
        xcd_barrier(xbar);
        {
            PHASE_PTRS();
            pg8::Gemm g{XB, WFF1 + (size_t)l * DFF * DM, NTOK, DFF, DM}; pg8::StaticOrder S; S.init(NTOK, DFF, G, bid);
            pg8::EpiFF1 E{HID};
            pg8::gemm_phase<pg8::EpiFF1, pg8::StaticOrder, true, true>(lds, g, S, E);
        }
        xcd_barrier(xbar);
        {
            PHASE_PTRS();
            pg8::Gemm g{HID, WFF2 + (size_t)l * DM * DFF, NTOK, DM, DFF}; pg8::StaticOrder S; S.init(NTOK, DM, G, bid);
            pg8::EpiRes E{XB, l == 1 ? kp->out : nullptr, STATS2, l == 1 ? nullptr : STATS, lds};
            pg8::gemm_phase<pg8::EpiRes, pg8::StaticOrder, true, true>(lds, g, S, E);
        }
        if (l == 0) xcd_barrier(xbar);
    }
}

extern "C" void kernel_launch(void* const* d_in, const int* in_sizes, int n_in, void* d_out, int out_size, void* d_ws, size_t ws_size, hipStream_t stream) {
    static int grid_blocks = 0;
    if (grid_blocks == 0) {
        if (n_in != 16 || out_size != NTOK * DM || ws_size < WS_END) { fprintf(stderr, "kernel_launch: unexpected shapes: n_in %d out %d ws %zu\n", n_in, out_size, ws_size); grid_blocks = -1; return; }
        int dev = 0, cus = 0, per_cu = 0;
        hipGetDevice(&dev);
        hipDeviceGetAttribute(&cus, hipDeviceAttributeMultiprocessorCount, dev);
        if (hipFuncSetAttribute((const void*)fwd_megakernel, hipFuncAttributeMaxDynamicSharedMemorySize, LDS_BYTES) != hipSuccess) { fprintf(stderr, "kernel_launch: hipFuncSetAttribute failed\n"); grid_blocks = -1; return; }
        if (hipOccupancyMaxActiveBlocksPerMultiprocessor(&per_cu, (const void*)fwd_megakernel, 512, LDS_BYTES) != hipSuccess || per_cu < 1) { fprintf(stderr, "kernel_launch: occupancy query gave %d\n", per_cu); per_cu = 1; }
        (void)hipGetLastError();
        grid_blocks = cus * 1;
    }
    if (grid_blocks < 0) return;
    Params p{};
    p.x_prompt = (const float*)d_in[0]; p.x_sample = (const float*)d_in[1]; p.mem_prompt = (const float*)d_in[2]; p.mem_sample = (const float*)d_in[3];
    p.g_mix = (const float*)d_in[4]; p.w_in = (const float*)d_in[5]; p.qk_gain = (const float*)d_in[6]; p.sink = (const float*)d_in[7]; p.rpb = (const float*)d_in[8];
    p.o_gain = (const float*)d_in[9]; p.w_out = (const float*)d_in[10]; p.g_mem = (const float*)d_in[11]; p.w_mem_kv = (const float*)d_in[12]; p.g_ff = (const float*)d_in[13];
    p.w_ff1 = (const float*)d_in[14]; p.w_ff2 = (const float*)d_in[15];
    p.out = (float*)d_out; p.ws = (unsigned char*)d_ws;
    if (hipMemsetAsync((char*)d_ws + WS_CTL, 0, CTL_BYTES, stream) != hipSuccess) { fprintf(stderr, "kernel_launch: hipMemsetAsync failed\n"); return; }
    void* args[] = {&p};
    hipError_t e = hipLaunchCooperativeKernel((const void*)fwd_megakernel, dim3(grid_blocks), dim3(512), args, LDS_BYTES, stream);
    if (e != hipSuccess) fprintf(stderr, "kernel_launch: cooperative launch failed: %s (grid %d)\n", hipGetErrorString(e), grid_blocks);
}
```
